# Optimizing an MI355X kernel written in HIP

```python
import math
import jax, jax.numpy as jnp
from jax import lax
import numpy as np

D_MODEL = 2048
BATCH = 4
SEQ = 4096
DEPTH = 1

D_MIX = D_MODEL
POOL_WIDTH = D_MIX // 2
SSM_WIDTH = D_MIX - POOL_WIDTH
POOL_WINDOWS = (2, 4, 8, 16)
N_POOL_GROUPS = len(POOL_WINDOWS)
POOL_GROUP = POOL_WIDTH // N_POOL_GROUPS
SSM_GROUP = 16
N_SSM_GROUPS = SSM_WIDTH // SSM_GROUP
SSM_STATE = 64
PLE_DIM = 256
EPS = 1e-6
DT_MIN = 1e-3
DT_MAX = 1e-1
A_RE_MAX = -1e-4

kernel_name = "hybrid_pool_s5_parallel_heads"


def rmsnorm(x, gain):
    x32 = x.astype(jnp.float32)
    y = x32 * lax.rsqrt(jnp.mean(x32 * x32, axis=-1, keepdims=True) + EPS)
    return (y * gain.astype(jnp.float32)).astype(x.dtype)


def pool_mixer(u, w_pool, pool_scale):
    B, L, _ = u.shape
    ug = u.astype(jnp.float32).reshape(B, L, N_POOL_GROUPS, POOL_GROUP)
    t = jnp.arange(L)
    outs = []
    for g, w in enumerate(POOL_WINDOWS):
        v = ug[:, :, g]
        cs = jnp.cumsum(v, axis=1)
        lagged = jnp.pad(cs, ((0, 0), (w, 0), (0, 0)))[:, :L]
        count = jnp.minimum(t + 1, w).astype(jnp.float32)[None, :, None]
        outs.append((cs - lagged) / count - v)
    pooled = jnp.stack(outs, axis=2)
    mixed = jnp.einsum('blgc,gcd->blgd', pooled, w_pool.astype(jnp.float32))
    out = mixed.reshape(B, L, POOL_WIDTH) * pool_scale.astype(jnp.float32)
    return out.astype(u.dtype)


def _scan_combine(e1, e2):
    ar1, ai1, br1, bi1 = e1
    ar2, ai2, br2, bi2 = e2
    ar = ar2 * ar1 - ai2 * ai1
    ai = ar2 * ai1 + ai2 * ar1
    br = ar2 * br1 - ai2 * bi1 + br2
    bi = ar2 * bi1 + ai2 * br1 + bi2
    return (ar, ai, br, bi)


def ssm_mixer(u, a_re, a_im, log_dt, b_re, b_im, c_re, c_im, d_skip, w_glu):
    B, L, _ = u.shape
    f32 = jnp.float32
    u32 = u.astype(f32).reshape(B, L, N_SSM_GROUPS, SSM_GROUP)
    lam_re = jnp.minimum(a_re.astype(f32), A_RE_MAX)
    lam_im = a_im.astype(f32)
    dt = jnp.exp(log_dt.astype(f32))[:, None]
    mag = jnp.exp(lam_re * dt)
    ang = lam_im * dt
    ab_re = mag * jnp.cos(ang)
    ab_im = mag * jnp.sin(ang)
    den = lam_re * lam_re + lam_im * lam_im
    n_re = ab_re - 1.0
    n_im = ab_im
    q_re = (n_re * lam_re + n_im * lam_im) / den
    q_im = (n_im * lam_re - n_re * lam_im) / den
    br = b_re.astype(f32)
    bi = b_im.astype(f32)
    bb_re = q_re[..., None] * br - q_im[..., None] * bi
    bb_im = q_re[..., None] * bi + q_im[..., None] * br
    bu_re = jnp.einsum('blgc,gnc->blgn', u32, bb_re)
    bu_im = jnp.einsum('blgc,gnc->blgn', u32, bb_im)
    shp = (1, L, N_SSM_GROUPS, SSM_STATE)
    a_re_t = jnp.broadcast_to(ab_re[None, None], shp)
    a_im_t = jnp.broadcast_to(ab_im[None, None], shp)
    _, _, s_re, s_im = lax.associative_scan(
        _scan_combine, (a_re_t, a_im_t, bu_re, bu_im), axis=1)
    y = (jnp.einsum('blgn,gcn->blgc', s_re, c_re.astype(f32))
         - jnp.einsum('blgn,gcn->blgc', s_im, c_im.astype(f32))
         + d_skip.astype(f32).reshape(N_SSM_GROUPS, SSM_GROUP) * u32)
    y = y.reshape(B, L, SSM_WIDTH)
    g = jax.nn.gelu(y)
    hg = g @ w_glu.astype(f32)
    out = hg[..., :SSM_WIDTH] * jax.nn.sigmoid(hg[..., SSM_WIDTH:])
    return out.astype(u.dtype)


def setup_inputs(seed: int = 0) -> dict:
    key = jax.random.key(seed)
    ks = jax.random.split(key, 20)
    f32 = jnp.float32
    n = lambda k, shape, s: jax.random.normal(k, shape, f32) * s
    x = jax.random.normal(ks[0], (BATCH, SEQ, D_MODEL), f32)
    p = jax.random.normal(ks[1], (DEPTH, BATCH, SEQ, PLE_DIM), f32)
    norm_gain = 1.0 + n(ks[2], (DEPTH, D_MODEL), 0.02)
    w_in = n(ks[3], (DEPTH, D_MODEL, 2 * D_MIX), D_MODEL ** -0.5)
    w_pool = n(ks[4], (DEPTH, N_POOL_GROUPS, POOL_GROUP, POOL_GROUP), POOL_GROUP ** -0.5)
    pool_scale = 1.0 + n(ks[5], (DEPTH, POOL_WIDTH), 0.02)
    a_re = -0.5 + n(ks[6], (DEPTH, N_SSM_GROUPS, SSM_STATE), 0.01)
    a_im = (math.pi * jnp.arange(SSM_STATE, dtype=f32))[None, None, :] + n(
        ks[7], (DEPTH, N_SSM_GROUPS, SSM_STATE), 0.01)
    log_dt = jax.random.uniform(ks[8], (DEPTH, N_SSM_GROUPS), f32,
                                math.log(DT_MIN), math.log(DT_MAX))
    b_scale = (2.0 * SSM_GROUP) ** -0.5
    b_re = n(ks[9], (DEPTH, N_SSM_GROUPS, SSM_STATE, SSM_GROUP), b_scale)
    b_im = n(ks[10], (DEPTH, N_SSM_GROUPS, SSM_STATE, SSM_GROUP), b_scale)
    c_scale = SSM_STATE ** -0.5
    c_re = n(ks[11], (DEPTH, N_SSM_GROUPS, SSM_GROUP, SSM_STATE), c_scale)
    c_im = n(ks[12], (DEPTH, N_SSM_GROUPS, SSM_GROUP, SSM_STATE), c_scale)
    d_skip = n(ks[13], (DEPTH, SSM_WIDTH), 1.0)
    w_glu = n(ks[14], (DEPTH, SSM_WIDTH, 2 * SSM_WIDTH), SSM_WIDTH ** -0.5)
    w_out = n(ks[15], (DEPTH, D_MIX, D_MODEL), D_MIX ** -0.5)
    w_ple = n(ks[16], (DEPTH, PLE_DIM, D_MODEL), PLE_DIM ** -0.5)
    w_ple_gate = n(ks[17], (DEPTH, D_MODEL, D_MODEL), D_MODEL ** -0.5)
    final_gain = 1.0 + n(ks[18], (D_MODEL,), 0.02)
    return {"x": x, "p": p, "norm_gain": norm_gain, "w_in": w_in, "w_pool": w_pool,
            "pool_scale": pool_scale, "a_re": a_re, "a_im": a_im, "log_dt": log_dt,
            "b_re": b_re, "b_im": b_im, "c_re": c_re, "c_im": c_im, "d_skip": d_skip,
            "w_glu": w_glu, "w_out": w_out, "w_ple": w_ple, "w_ple_gate": w_ple_gate,
            "final_gain": final_gain}


def reference(x, p, norm_gain, w_in, w_pool, pool_scale, a_re, a_im, log_dt, b_re, b_im,
              c_re, c_im, d_skip, w_glu, w_out, w_ple, w_ple_gate, final_gain):
    h = x
    for i in range(DEPTH):
        hn = rmsnorm(h, norm_gain[i])
        proj = hn @ w_in[i]
        pool_in = proj[..., :POOL_WIDTH]
        pool_gate = proj[..., POOL_WIDTH:2 * POOL_WIDTH]
        ssm_in = proj[..., 2 * POOL_WIDTH:2 * POOL_WIDTH + SSM_WIDTH]
        ssm_gate = proj[..., 2 * POOL_WIDTH + SSM_WIDTH:]
        ya = pool_mixer(pool_in, w_pool[i], pool_scale[i]) * jax.nn.silu(pool_gate)
        yb = ssm_mixer(ssm_in, a_re[i], a_im[i], log_dt[i], b_re[i], b_im[i],
                       c_re[i], c_im[i], d_skip[i], w_glu[i]) * jax.nn.silu(ssm_gate)
        h = h + jnp.concatenate([ya, yb], axis=-1) @ w_out[i]
        h = h + (p[i] @ w_ple[i]) * jax.nn.sigmoid(h @ w_ple_gate[i])
    return rmsnorm(h, final_gain)
```

```cpp
#include <hip/hip_runtime.h>
#include <cstdio>
#include <cstdint>

namespace {
constexpr int DM = 2048, BATCH = 4, SEQ = 4096, M = BATCH * SEQ;
constexpr int PW = 1024, SW = 1024, NPROJ = 4096, PLE = 256;
constexpr int SG = 16, NG = 64, NS = 64;
constexpr float EPS = 1e-6f;

__global__ void k_rstd(const float* __restrict__ x, float* __restrict__ rstd, int ncols) {
    const int row = blockIdx.x * (blockDim.x >> 6) + (threadIdx.x >> 6), lane = threadIdx.x & 63;
    const float* xr = x + (size_t)row * ncols;
    float s = 0.f;
    for (int c = lane; c < ncols; c += 64) { const float v = xr[c]; s += v * v; }
    for (int o = 32; o > 0; o >>= 1) s += __shfl_xor(s, o);
    if (lane == 0) rstd[row] = 1.0f / sqrtf(s / (float)ncols + EPS);
}

__global__ void __launch_bounds__(256) k_gemm(const float* __restrict__ A, int lda, long sA, const float* __restrict__ W, int ldw, long sW,
                                              float* __restrict__ C, int ldc, long sC, int K, const float* __restrict__ colscale, const float* __restrict__ rowscale) {
    __shared__ float As[16][65];
    __shared__ float Bs[16][64];
    A += (size_t)blockIdx.z * sA; W += (size_t)blockIdx.z * sW; C += (size_t)blockIdx.z * sC;
    const int tid = threadIdx.x, tx = tid & 15, ty = tid >> 4;
    const int m0 = blockIdx.y * 64, n0 = blockIdx.x * 64;
    float acc[4][4];
#pragma unroll
    for (int i = 0; i < 4; ++i)
#pragma unroll
        for (int j = 0; j < 4; ++j) acc[i][j] = 0.f;
    for (int k0 = 0; k0 < K; k0 += 16) {
#pragma unroll
        for (int i = 0; i < 4; ++i) { const int e = tid + i * 256, r = e >> 4, c = e & 15; float v = A[(size_t)(m0 + r) * lda + k0 + c]; if (colscale) v *= colscale[k0 + c]; As[c][r] = v; }
#pragma unroll
        for (int i = 0; i < 4; ++i) { const int e = tid + i * 256, r = e >> 6, c = e & 63; Bs[r][c] = W[(size_t)(k0 + r) * ldw + n0 + c]; }
        __syncthreads();
#pragma unroll
        for (int kk = 0; kk < 16; ++kk) {
            float a[4], b[4];
#pragma unroll
            for (int i = 0; i < 4; ++i) a[i] = As[kk][ty * 4 + i];
#pragma unroll
            for (int j = 0; j < 4; ++j) b[j] = Bs[kk][tx * 4 + j];
#pragma unroll
            for (int i = 0; i < 4; ++i)
#pragma unroll
                for (int j = 0; j < 4; ++j) acc[i][j] = fmaf(a[i], b[j], acc[i][j]);
        }
        __syncthreads();
    }
#pragma unroll
    for (int i = 0; i < 4; ++i) { const int r = m0 + ty * 4 + i; const float rs = rowscale ? rowscale[r] : 1.f;
#pragma unroll
        for (int j = 0; j < 4; ++j) C[(size_t)r * ldc + n0 + tx * 4 + j] = acc[i][j] * rs; }
}

__device__ __forceinline__ float sigmoidf_(float v) { return 1.0f / (1.0f + expf(-v)); }
__device__ __forceinline__ float siluf_(float v) { return v * sigmoidf_(v); }
__device__ __forceinline__ float gelu_tanh(float y) { return 0.5f * y * (1.0f + tanhf(0.7978845608028654f * (y + 0.044715f * y * y * y))); }

__global__ void k_pool(const float* __restrict__ proj, float* __restrict__ pooled) {
    const size_t idx = (size_t)blockIdx.x * blockDim.x + threadIdx.x;
    const int j = (int)(idx & 1023); const int m = (int)(idx >> 10); const int t = m & (SEQ - 1);
    const int w = 2 << (j >> 8);
    const int cnt = (t + 1 < w) ? (t + 1) : w;
    float s = 0.f;
    for (int d = 0; d < cnt; ++d) s += proj[(size_t)(m - d) * NPROJ + j];
    pooled[idx] = s / (float)cnt - proj[(size_t)m * NPROJ + j];
}
__global__ void k_pool_epi(const float* __restrict__ mixed, const float* __restrict__ proj, const float* __restrict__ pool_scale, float* __restrict__ mix) {
    const size_t idx = (size_t)blockIdx.x * blockDim.x + threadIdx.x;
    const int j = (int)(idx & 1023); const size_t m = idx >> 10;
    mix[m * DM + j] = mixed[idx] * pool_scale[j] * siluf_(proj[m * NPROJ + PW + j]);
}

__global__ void __launch_bounds__(64) k_ssm(const float* __restrict__ proj, const float* __restrict__ a_re, const float* __restrict__ a_im, const float* __restrict__ log_dt,
                                            const float* __restrict__ b_re, const float* __restrict__ b_im, const float* __restrict__ c_re, const float* __restrict__ c_im,
                                            const float* __restrict__ d_skip, float* __restrict__ gbuf) {
    __shared__ float red[16][65];
    const int b = blockIdx.x / NG, g = blockIdx.x % NG, n = threadIdx.x;
    const float lre = fminf(a_re[g * NS + n], -1e-4f), lim = a_im[g * NS + n];
    const float dt = expf(log_dt[g]);
    const float mag = expf(lre * dt), ang = lim * dt;
    const float abr = mag * cosf(ang), abi = mag * sinf(ang);
    const float den = lre * lre + lim * lim;
    const float nre = abr - 1.0f, nim = abi;
    const float qre = (nre * lre + nim * lim) / den, qim = (nim * lre - nre * lim) / den;
    float bbr[16], bbi[16], cr[16], ci[16];
#pragma unroll
    for (int c = 0; c < 16; ++c) {
        const float br = b_re[(g * NS + n) * SG + c], bi = b_im[(g * NS + n) * SG + c];
        bbr[c] = qre * br - qim * bi; bbi[c] = qre * bi + qim * br;
        cr[c] = c_re[(g * SG + c) * NS + n]; ci[c] = c_im[(g * SG + c) * NS + n];
    }
    const int cc = n & 15, q = n >> 4;
    const float dsk = d_skip[g * SG + cc];
    float sre = 0.f, sim = 0.f;
    for (int t = 0; t < SEQ; ++t) {
        const float* up = proj + (size_t)(b * SEQ + t) * NPROJ + 2 * PW + g * SG;
        float u[16];
#pragma unroll
        for (int c = 0; c < 16; ++c) u[c] = up[c];
        float bur = 0.f, bui = 0.f;
#pragma unroll
        for (int c = 0; c < 16; ++c) { bur = fmaf(bbr[c], u[c], bur); bui = fmaf(bbi[c], u[c], bui); }
        const float nr = abr * sre - abi * sim + bur, ni = abr * sim + abi * sre + bui;
        sre = nr; sim = ni;
#pragma unroll
        for (int c = 0; c < 16; ++c) red[c][n] = sre * cr[c] - sim * ci[c];
        __syncthreads();
        float s = 0.f;
#pragma unroll
        for (int i = 0; i < 16; ++i) s += red[cc][q * 16 + i];
        s += __shfl_xor(s, 16); s += __shfl_xor(s, 32);
        if (q == 0) { const float y = s + dsk * up[cc]; gbuf[(size_t)(b * SEQ + t) * SW + cc + g * SG] = gelu_tanh(y); }
        __syncthreads();
    }
}
__global__ void k_glu_epi(const float* __restrict__ hg, const float* __restrict__ proj, float* __restrict__ mix) {
    const size_t idx = (size_t)blockIdx.x * blockDim.x + threadIdx.x;
    const int j = (int)(idx & 1023); const size_t m = idx >> 10;
    mix[m * DM + SW + j] = hg[m * 2048 + j] * sigmoidf_(hg[m * 2048 + 1024 + j]) * siluf_(proj[m * NPROJ + 3072 + j]);
}
__global__ void k_add(const float* __restrict__ a, float* __restrict__ io) { const size_t idx = (size_t)blockIdx.x * blockDim.x + threadIdx.x; io[idx] += a[idx]; }
__global__ void k_ple_epi(float* __restrict__ h, const float* __restrict__ pw, const float* __restrict__ gt) {
    const size_t idx = (size_t)blockIdx.x * blockDim.x + threadIdx.x; h[idx] += pw[idx] * sigmoidf_(gt[idx]);
}
__global__ void k_final(const float* __restrict__ h2, const float* __restrict__ rstd, const float* __restrict__ gain, float* __restrict__ out) {
    const size_t idx = (size_t)blockIdx.x * blockDim.x + threadIdx.x; const int j = (int)(idx & (DM - 1)); const size_t m = idx >> 11;
    out[idx] = h2[idx] * rstd[m] * gain[j];
}
}

extern "C" void kernel_launch(void* const* d_in, const int* in_sizes, int n_in, void* d_out, int out_size, void* d_ws, size_t ws_size, hipStream_t stream) {
    const float* x = (const float*)d_in[0];      const float* p = (const float*)d_in[1];      const float* norm_gain = (const float*)d_in[2];
    const float* w_in = (const float*)d_in[3];   const float* w_pool = (const float*)d_in[4]; const float* pool_scale = (const float*)d_in[5];
    const float* a_re = (const float*)d_in[6];   const float* a_im = (const float*)d_in[7];   const float* log_dt = (const float*)d_in[8];
    const float* b_re = (const float*)d_in[9];   const float* b_im = (const float*)d_in[10];  const float* c_re = (const float*)d_in[11];
    const float* c_im = (const float*)d_in[12];  const float* d_skip = (const float*)d_in[13]; const float* w_glu = (const float*)d_in[14];
    const float* w_out = (const float*)d_in[15]; const float* w_ple = (const float*)d_in[16]; const float* w_gate = (const float*)d_in[17];
    const float* final_gain = (const float*)d_in[18];
    float* out = (float*)d_out;
    const size_t MiB = 1u << 20;
    if (ws_size < 512 * MiB) { fprintf(stderr, "ws too small: %zu\n", ws_size); return; }
    char* ws = (char*)d_ws;
    float* proj = (float*)(ws);
    float* gbuf = (float*)(ws + 256 * MiB);
    float* mix = (float*)(ws + 320 * MiB);
    float* rstd = (float*)(ws + 448 * MiB);
    float* pooled = out;
    float* hg = out;
    float* h = proj; float* pw = (float*)(ws + 128 * MiB); float* gt = out;

    k_rstd<<<M / 4, 256, 0, stream>>>(x, rstd, DM);
    k_gemm<<<dim3(NPROJ / 64, M / 64, 1), 256, 0, stream>>>(x, DM, 0, w_in, NPROJ, 0, proj, NPROJ, 0, DM, norm_gain, rstd);
    k_pool<<<(M * 1024) / 256, 256, 0, stream>>>(proj, pooled);
    k_gemm<<<dim3(256 / 64, M / 64, 4), 256, 0, stream>>>(pooled, PW, 256, w_pool, 256, 65536, gbuf, PW, 256, 256, nullptr, nullptr);
    k_pool_epi<<<(M * 1024) / 256, 256, 0, stream>>>(gbuf, proj, pool_scale, mix);
    k_ssm<<<BATCH * NG, 64, 0, stream>>>(proj, a_re, a_im, log_dt, b_re, b_im, c_re, c_im, d_skip, gbuf);
    k_gemm<<<dim3(2048 / 64, M / 64, 1), 256, 0, stream>>>(gbuf, SW, 0, w_glu, 2048, 0, hg, 2048, 0, SW, nullptr, nullptr);
    k_glu_epi<<<(M * 1024) / 256, 256, 0, stream>>>(hg, proj, mix);
    k_gemm<<<dim3(DM / 64, M / 64, 1), 256, 0, stream>>>(mix, DM, 0, w_out, DM, 0, h, DM, 0, DM, nullptr, nullptr);
    k_add<<<(M * DM) / 256, 256, 0, stream>>>(x, h);
    k_gemm<<<dim3(DM / 64, M / 64, 1), 256, 0, stream>>>(p, PLE, 0, w_ple, DM, 0, pw, DM, 0, PLE, nullptr, nullptr);
    k_gemm<<<dim3(DM / 64, M / 64, 1), 256, 0, stream>>>(h, DM, 0, w_gate, DM, 0, gt, DM, 0, DM, nullptr, nullptr);
    k_ple_epi<<<(M * DM) / 256, 256, 0, stream>>>(h, pw, gt);
    k_rstd<<<M / 4, 256, 0, stream>>>(h, rstd, DM);
    k_final<<<(M * DM) / 256, 256, 0, stream>>>(h, rstd, final_gain, out);
}
```

```cpp
#include <hip/hip_runtime.h>
#include <cstdio>
#include <cstdint>
namespace pg8 {
#define PG8_LAS __attribute__((address_space(3)))
typedef unsigned short bf16_t;
typedef short bf16x8 __attribute__((ext_vector_type(8)));
typedef float f32x4 __attribute__((ext_vector_type(4)));
typedef unsigned u32x4 __attribute__((ext_vector_type(4)));
constexpr int BM = 256, BK = 64, HALF = 128, HTB = HALF * BK * 2  , STAGE_BYTES = 8 * HTB, NXCD = 8, WGM = 8;

__host__ __device__ __forceinline__ int lds_byte(int r, int c) { const int st = (r >> 4) * 2 + (c >> 5), rr = r & 15, cc = c & 31, ob = rr * 64 + cc * 2; return st * 1024 + (ob ^ (((ob >> 9) & 1) << 5)); }
__host__ __device__ __forceinline__ void stage_rc(int b, int& R, int& C) { const int st = b / 1024, sb = b % 1024, swz = sb ^ (((sb >> 9) & 1) << 5); R = (st >> 1) * 16 + swz / 64; C = (st & 1) * 32 + (swz % 64) / 2; }
__host__ __device__ __forceinline__ int perm32(int rho) { const int n = rho >> 4, i = rho & 15; return 8 * (i >> 2) + 4 * n + (i & 3); }

struct Unit { int pm, pn; };
struct Gemm { const bf16_t* A; const bf16_t* Bt; int M, N, K; };

struct StaticOrder {
    int nM, nN, nwg, G, c;
    __host__ __device__ void init(int M, int N, int G_, int c_) { nM = M / BM; nN = N / BM; nwg = nM * nN; G = G_; c = c_; }
    __host__ __device__ bool next(int i, Unit& u) const {
        const long L = (long)i * G + c; if (L >= nwg) return false;
        int wgid = (int)L; { const int q = nwg / NXCD, r = nwg % NXCD, xcd = wgid % NXCD, off = wgid / NXCD; wgid = (xcd < r ? xcd * (q + 1) : r * (q + 1) + (xcd - r) * q) + off; }
        const int nig = WGM * nN, gid = wgid / nig, fm = gid * WGM, gsz = (nM - fm) < WGM ? (nM - fm) : WGM;
        u.pm = fm + ((wgid % nig) % gsz); u.pn = (wgid % nig) / gsz; return true;
    }
    __device__ __forceinline__ void a_ready(const Unit&) const {}
    __device__ __forceinline__ void done(const Unit&) const {}
};

__device__ __forceinline__ unsigned cvt_pk_bf16(float lo, float hi) { unsigned r; asm volatile("v_cvt_pk_bf16_f32 %0, %1, %2" : "=v"(r) : "v"(lo), "v"(hi)); return r; }
typedef float f32x2 __attribute__((ext_vector_type(2)));
__device__ __forceinline__ float fsigmoid(float v) { return __builtin_amdgcn_rcpf(1.0f + __builtin_amdgcn_exp2f(-1.4426950408889634f * v)); }
__device__ __forceinline__ float bf_lo(unsigned w) { return __uint_as_float(w << 16); }
__device__ __forceinline__ float bf_hi(unsigned w) { return __uint_as_float(w & 0xffff0000u); }
__device__ __forceinline__ u32x4 pack8(const f32x4 a, const f32x4 b) { u32x4 w; w.x = cvt_pk_bf16(a[0], a[1]); w.y = cvt_pk_bf16(a[2], a[3]); w.z = cvt_pk_bf16(b[0], b[1]); w.w = cvt_pk_bf16(b[2], b[3]); return w; }

struct EpiProj {
    static constexpr bool PERM = true, AFTER_DRAIN = false;
    bf16_t* O; const float* rstd; int ldc;
    __device__ __forceinline__ void operator()(const f32x4 (&acc)[2][2][4][2], const Unit& u, int wr, int wc, int fr, int fq) const {
        const int row0 = u.pm * BM + wr * 64 + fr, col0 = u.pn * BM + wc * 32 + 8 * fq; const bool gate = ((u.pn >> 2) & 1) != 0;
#pragma unroll
        for (int ai = 0; ai < 2; ++ai)
#pragma unroll
            for (int m = 0; m < 4; ++m) { const int row = row0 + ai * HALF + m * 16; const float rs = rstd[row]; bf16_t* rowp = O + (size_t)row * ldc + col0;
#pragma unroll
                for (int bj = 0; bj < 2; ++bj) { f32x4 v0 = acc[ai][bj][m][0] * rs, v1 = acc[ai][bj][m][1] * rs;
                    if (gate) {
#pragma unroll
                        for (int i = 0; i < 4; ++i) { v0[i] = v0[i] * fsigmoid(v0[i]); v1[i] = v1[i] * fsigmoid(v1[i]); } }
                    *(u32x4*)(rowp + bj * HALF) = pack8(v0, v1); } }
    }
};
struct EpiStore {
    static constexpr bool PERM = true, AFTER_DRAIN = false;
    bf16_t* O; int ldc;
    __device__ __forceinline__ void operator()(const f32x4 (&acc)[2][2][4][2], const Unit& u, int wr, int wc, int fr, int fq) const {
        const int row0 = u.pm * BM + wr * 64 + fr, col0 = u.pn * BM + wc * 32 + 8 * fq;
#pragma unroll
        for (int ai = 0; ai < 2; ++ai)
#pragma unroll
            for (int m = 0; m < 4; ++m) { bf16_t* rowp = O + (size_t)(row0 + ai * HALF + m * 16) * ldc + col0;
#pragma unroll
                for (int bj = 0; bj < 2; ++bj) *(u32x4*)(rowp + bj * HALF) = pack8(acc[ai][bj][m][0], acc[ai][bj][m][1]); }
    }
};
struct EpiGlu {
    static constexpr bool PERM = true, AFTER_DRAIN = false;
    bf16_t* mix; const bf16_t* proj;
    __device__ __forceinline__ void operator()(const f32x4 (&acc)[2][2][4][2], const Unit& u, int wr, int wc, int fr, int fq) const {
        const int row0 = u.pm * BM + wr * 64 + fr, colg = u.pn * HALF + wc * 32 + 8 * fq;
#pragma unroll
        for (int ai = 0; ai < 2; ++ai)
#pragma unroll
            for (int m = 0; m < 4; ++m) { const int row = row0 + ai * HALF + m * 16;
                const u32x4 sg = *(const u32x4*)(proj + (size_t)row * 4096 + 3072 + colg);
                const f32x4 s0 = (f32x4){bf_lo(sg.x), bf_hi(sg.x), bf_lo(sg.y), bf_hi(sg.y)}, s1 = (f32x4){bf_lo(sg.z), bf_hi(sg.z), bf_lo(sg.w), bf_hi(sg.w)};
                f32x4 o0, o1;
#pragma unroll
                for (int i = 0; i < 4; ++i) { o0[i] = acc[ai][0][m][0][i] * fsigmoid(acc[ai][1][m][0][i]) * s0[i]; o1[i] = acc[ai][0][m][1][i] * fsigmoid(acc[ai][1][m][1][i]) * s1[i]; }
                *(u32x4*)(mix + (size_t)row * 2048 + 1024 + colg) = pack8(o0, o1); }
    }
};
struct EpiH {
    static constexpr bool PERM = true, AFTER_DRAIN = false;
    const float* x; float* h; bf16_t* hb;
    __device__ __forceinline__ void operator()(const f32x4 (&acc)[2][2][4][2], const Unit& u, int wr, int wc, int fr, int fq) const {
        const int row0 = u.pm * BM + wr * 64 + fr, col0 = u.pn * BM + wc * 32 + 8 * fq;
#pragma unroll
        for (int ai = 0; ai < 2; ++ai)
#pragma unroll
            for (int m = 0; m < 4; ++m) { const size_t rb = (size_t)(row0 + ai * HALF + m * 16) * 2048 + col0;
#pragma unroll
                for (int bj = 0; bj < 2; ++bj) { const size_t off = rb + bj * HALF;
                    const f32x4 h0 = *(const f32x4*)(x + off) + acc[ai][bj][m][0], h1 = *(const f32x4*)(x + off + 4) + acc[ai][bj][m][1];
                    *(f32x4*)(h + off) = h0; *(f32x4*)(h + off + 4) = h1; *(u32x4*)(hb + off) = pack8(h0, h1); } }
    }
};
struct EpiGate {
    static constexpr bool PERM = true, AFTER_DRAIN = false;
    float* h; const bf16_t* ple; float* ssq;
    __device__ __forceinline__ void operator()(const f32x4 (&acc)[2][2][4][2], const Unit& u, int wr, int wc, int fr, int fq) const {
        const int row0 = u.pm * BM + wr * 64 + fr, col0 = u.pn * BM + wc * 32 + 8 * fq;
#pragma unroll
        for (int ai = 0; ai < 2; ++ai)
#pragma unroll
            for (int m = 0; m < 4; ++m) { const int row = row0 + ai * HALF + m * 16; const size_t rb = (size_t)row * 2048 + col0; float q = 0.f;
#pragma unroll
                for (int bj = 0; bj < 2; ++bj) { const size_t off = rb + bj * HALF;
                    f32x4 h0 = *(const f32x4*)(h + off), h1 = *(const f32x4*)(h + off + 4); const u32x4 pl = *(const u32x4*)(ple + off);
                    const f32x4 p0 = (f32x4){bf_lo(pl.x), bf_hi(pl.x), bf_lo(pl.y), bf_hi(pl.y)}, p1 = (f32x4){bf_lo(pl.z), bf_hi(pl.z), bf_lo(pl.w), bf_hi(pl.w)};
#pragma unroll
                    for (int i = 0; i < 4; ++i) { h0[i] += p0[i] * fsigmoid(acc[ai][bj][m][0][i]); h1[i] += p1[i] * fsigmoid(acc[ai][bj][m][1][i]); q += h0[i] * h0[i] + h1[i] * h1[i]; }
                    *(f32x4*)(h + off) = h0; *(f32x4*)(h + off + 4) = h1; }
                q += __shfl_xor(q, 16); q += __shfl_xor(q, 32);
                if (fq == 0) ssq[(size_t)row * 32 + u.pn * 4 + wc] = q; }
    }
};

template <class Epi, class Sched, bool ALIGN_EPI = false, bool SP2 = false>
__device__ __forceinline__ void gemm_phase(PG8_LAS unsigned char* lds, const Gemm g, const Sched& S, const Epi& E, const int wave_id) {
    int lane_; asm volatile("v_mbcnt_lo_u32_b32 %0, -1, 0\n\tv_mbcnt_hi_u32_b32 %0, -1, %0" : "=v"(lane_));
    const int wid = wave_id, tid = wave_id * 64 + lane_, lane = tid & 63, wr = wid >> 2, wc = wid & 3, fr = lane & 15, fq = lane >> 4;
    const int K = g.K, nt = K / BK;
    unsigned voffA[2], voffB[2];
#pragma unroll
    for (int i = 0; i < 2; ++i) { int R, C; stage_rc(tid * 16 + i * 8192, R, C); const int Rb = Epi::PERM ? ((R & ~31) + perm32(R & 31)) : R;
        voffA[i] = (unsigned)(R * K + C) * 2u; voffB[i] = (unsigned)(Rb * K + C) * 2u; }
    const size_t kstep = (size_t)(BK * 2);
    const size_t hstep = (size_t)HALF * K * 2;
    const size_t tstep = 2 * hstep;
    const unsigned ldsw = (unsigned)wid * 1024u;
    const int aoff = lds_byte(wr * 64 + fr, fq * 8), boff = lds_byte(wc * 32 + fr, fq * 8);
#define PG8_SA(b, h) (((b) * 2 + (h)) * HTB)
#define PG8_SB(b, h) ((4 + (b) * 2 + (h)) * HTB)
#define PG8_STAGE(bufoff, gbase, voff) do { _Pragma("unroll") for (int _i = 0; _i < 2; ++_i) \
        __builtin_amdgcn_global_load_lds((const unsigned*)((const char*)(gbase) + (voff)[_i]), (PG8_LAS unsigned*)(lds + (bufoff) + ldsw + _i * 8192), 16, 0, 0); } while (0)
#define PG8_LDA(dst, b, h) do { _Pragma("unroll") for (int m = 0; m < 4; ++m) _Pragma("unroll") for (int k = 0; k < 2; ++k) dst[m][k] = *(const PG8_LAS bf16x8*)(lds + PG8_SA(b, h) + aoff + m * 2048 + k * 1024); } while (0)
#define PG8_LDB(dst, b, h) do { _Pragma("unroll") for (int n = 0; n < 2; ++n) _Pragma("unroll") for (int k = 0; k < 2; ++k) dst[n][k] = *(const PG8_LAS bf16x8*)(lds + PG8_SB(b, h) + boff + n * 2048 + k * 1024); } while (0)
#define PG8_MMA(ai, bj, At, Bt) do { __builtin_amdgcn_s_setprio(1); _Pragma("unroll") for (int m = 0; m < 4; ++m) _Pragma("unroll") for (int n = 0; n < 2; ++n) _Pragma("unroll") for (int k = 0; k < 2; ++k) \
        acc[ai][bj][m][n] = __builtin_amdgcn_mfma_f32_16x16x32_bf16(Bt[n][k], At[m][k], acc[ai][bj][m][n], 0, 0, 0); __builtin_amdgcn_s_setprio(0); } while (0)
#define PG8_WAIT_V(n) asm volatile("s_waitcnt vmcnt(" #n ")" ::: "memory")
#define PG8_WAIT_L(n) asm volatile("s_waitcnt lgkmcnt(" #n ")" ::: "memory")
#define PG8_BAR __builtin_amdgcn_s_barrier()
#define PG8_SCHED __builtin_amdgcn_sched_barrier(0)
    Unit cur, nxt; int ui = 0;
    if (!S.next(0, cur)) return;
    f32x4 acc[2][2][4][2];
#pragma unroll
    for (int a = 0; a < 2; ++a)
#pragma unroll
        for (int b = 0; b < 2; ++b)
#pragma unroll
            for (int m = 0; m < 4; ++m)
#pragma unroll
                for (int n = 0; n < 2; ++n) acc[a][b][m][n] = (f32x4){0.f, 0.f, 0.f, 0.f};
    bf16x8 At[4][2], B0[2][2], B1[2][2];
    const char* cA = (const char*)g.A + (size_t)cur.pm * tstep; const char* cB = (const char*)g.Bt + (size_t)cur.pn * tstep;
    S.a_ready(cur);
    if constexpr (SP2) {
        PG8_STAGE(PG8_SB(0, 0), cB, voffB); PG8_STAGE(PG8_SB(0, 1), cB + hstep, voffB); PG8_STAGE(PG8_SA(0, 0), cA, voffA); PG8_STAGE(PG8_SA(0, 1), cA + hstep, voffA);
        if (wr == 1) PG8_BAR;
        PG8_WAIT_V(2); PG8_BAR;
        PG8_STAGE(PG8_SB(1, 0), cB + kstep, voffB); PG8_STAGE(PG8_SA(1, 0), cA + kstep, voffA); PG8_STAGE(PG8_SB(1, 1), cB + hstep + kstep, voffB);
        PG8_WAIT_V(6); PG8_BAR;
    } else {
        PG8_STAGE(PG8_SB(0, 0), cB, voffB); PG8_STAGE(PG8_SA(0, 0), cA, voffA); PG8_STAGE(PG8_SB(0, 1), cB + hstep, voffB); PG8_STAGE(PG8_SA(0, 1), cA + hstep, voffA);
        if (wr == 1) PG8_BAR;
        PG8_WAIT_V(4); PG8_BAR;
        PG8_STAGE(PG8_SB(1, 0), cB + kstep, voffB); PG8_STAGE(PG8_SA(1, 0), cA + kstep, voffA); PG8_STAGE(PG8_SB(1, 1), cB + hstep + kstep, voffB);
        PG8_WAIT_V(6); PG8_BAR;
    }
    for (;;) {
        const bool has_next = S.next(ui + 1, nxt);
        const char* nA = has_next ? (const char*)g.A + (size_t)nxt.pm * tstep : cA; const char* nB = has_next ? (const char*)g.Bt + (size_t)nxt.pn * tstep : cB;
        for (int t = 0; t < nt; t += 2) {
            const bool last = (t == nt - 2);
            const char* a1 = cA + (size_t)(t + 1) * kstep;
            const char* a2 = last ? nA : cA + (size_t)(t + 2) * kstep; const char* b2 = last ? nB : cB + (size_t)(t + 2) * kstep;
            const char* a3 = a2 + kstep; const char* b3 = b2 + kstep;
            if (last && has_next) S.a_ready(nxt);
            if constexpr (SP2) {
            PG8_LDB(B0, 0, 0); PG8_LDB(B1, 0, 1); PG8_SCHED; PG8_LDA(At, 0, 0); PG8_STAGE(PG8_SA(1, 1), a1 + hstep, voffA);
            PG8_WAIT_V(8); PG8_WAIT_L(0); PG8_BAR; PG8_MMA(0, 0, At, B0); PG8_MMA(0, 1, At, B1); PG8_BAR; PG8_SCHED;
            PG8_LDA(At, 0, 1); PG8_STAGE(PG8_SB(0, 0), b2, voffB); PG8_STAGE(PG8_SB(0, 1), b2 + hstep, voffB); PG8_STAGE(PG8_SA(0, 0), a2, voffA);
            PG8_WAIT_V(8); PG8_WAIT_L(0); PG8_BAR; PG8_MMA(1, 0, At, B0); PG8_MMA(1, 1, At, B1); PG8_BAR; PG8_SCHED;
            PG8_LDB(B0, 1, 0); PG8_LDB(B1, 1, 1); PG8_SCHED; PG8_LDA(At, 1, 0); PG8_STAGE(PG8_SA(0, 1), a2 + hstep, voffA);
            PG8_WAIT_V(8); PG8_WAIT_L(0); PG8_BAR; PG8_MMA(0, 0, At, B0); PG8_MMA(0, 1, At, B1); PG8_BAR; PG8_SCHED;
            PG8_LDA(At, 1, 1); PG8_STAGE(PG8_SB(1, 0), b3, voffB); PG8_STAGE(PG8_SB(1, 1), b3 + hstep, voffB); PG8_STAGE(PG8_SA(1, 0), a3, voffA);
            PG8_WAIT_V(8); PG8_WAIT_L(0); PG8_BAR; PG8_MMA(1, 0, At, B0); PG8_MMA(1, 1, At, B1); PG8_BAR; PG8_SCHED;
            } else {
            PG8_LDB(B0, 0, 0); PG8_SCHED; PG8_LDA(At, 0, 0); PG8_STAGE(PG8_SA(1, 1), a1 + hstep, voffA);
            PG8_WAIT_L(8); PG8_BAR; PG8_WAIT_L(0); PG8_MMA(0, 0, At, B0); PG8_BAR; PG8_SCHED;
            PG8_LDB(B1, 0, 1); PG8_STAGE(PG8_SB(0, 0), b2, voffB);
            PG8_BAR; PG8_WAIT_L(0); PG8_MMA(0, 1, At, B1); PG8_BAR;
            PG8_LDA(At, 0, 1); PG8_STAGE(PG8_SA(0, 0), a2, voffA);
            PG8_BAR; PG8_WAIT_L(0); PG8_MMA(1, 0, At, B0); PG8_BAR; PG8_SCHED;
            PG8_STAGE(PG8_SB(0, 1), b2 + hstep, voffB);
            PG8_WAIT_V(6); PG8_BAR; PG8_MMA(1, 1, At, B1); PG8_BAR;
            PG8_LDB(B0, 1, 0); PG8_SCHED; PG8_LDA(At, 1, 0); PG8_STAGE(PG8_SA(0, 1), a2 + hstep, voffA);
            PG8_WAIT_L(8); PG8_BAR; PG8_WAIT_L(0); PG8_MMA(0, 0, At, B0); PG8_BAR; PG8_SCHED;
            PG8_LDB(B1, 1, 1); PG8_STAGE(PG8_SB(1, 0), b3, voffB);
            PG8_BAR; PG8_WAIT_L(0); PG8_MMA(0, 1, At, B1); PG8_BAR;
            PG8_LDA(At, 1, 1); PG8_STAGE(PG8_SA(1, 0), a3, voffA);
            PG8_BAR; PG8_WAIT_L(0); PG8_MMA(1, 0, At, B0); PG8_BAR; PG8_SCHED;
            PG8_STAGE(PG8_SB(1, 1), b3 + hstep, voffB);
            PG8_WAIT_V(6); PG8_BAR; PG8_MMA(1, 1, At, B1); PG8_BAR;
            }
        }
        if constexpr (ALIGN_EPI) { if (wr == 0) PG8_BAR; }
        if constexpr (!Epi::AFTER_DRAIN) { E(acc, cur, wr, wc, fr, fq); S.done(cur); }
        if (!has_next) break;
#pragma unroll
        for (int a = 0; a < 2; ++a)
#pragma unroll
            for (int b = 0; b < 2; ++b)
#pragma unroll
                for (int m = 0; m < 4; ++m)
#pragma unroll
                    for (int n = 0; n < 2; ++n) acc[a][b][m][n] = (f32x4){0.f, 0.f, 0.f, 0.f};
        cur = nxt; cA = nA; cB = nB; ++ui;
        if constexpr (ALIGN_EPI) { if (wr == 1) PG8_BAR; }
    }
    PG8_WAIT_V(0);
    if constexpr (!ALIGN_EPI) { if (wr == 0) PG8_BAR; }
    PG8_BAR;
    if constexpr (Epi::AFTER_DRAIN) { E.fused(acc, cur, wr, wc, fr, fq, lds, wid, lane); S.done(cur); }
#undef PG8_SA
#undef PG8_SB
#undef PG8_STAGE
#undef PG8_LDA
#undef PG8_LDB
#undef PG8_MMA
#undef PG8_WAIT_V
#undef PG8_WAIT_L
#undef PG8_BAR
#undef PG8_SCHED
}
}
constexpr int NWAVES = 8;
constexpr int DM = 2048, NBATCH = 4, SEQ = 4096, M = NBATCH * SEQ;
constexpr int NPROJ = 4096, PW = 1024, SW = 1024, PLE = 256;
constexpr int NG = 64, SG = 16, NS = 64;
constexpr float RMS_EPS = 1e-6f;

constexpr size_t MiB = 1u << 20;
constexpr size_t WS_CTL = 0, CTL_ZERO_BYTES = 1 * MiB;
constexpr size_t WS_WIN = 1 * MiB;
constexpr size_t WS_WGLU = 17 * MiB;
constexpr size_t WS_WOUT = 21 * MiB;
constexpr size_t WS_WGATE = 29 * MiB;
constexpr size_t WS_WPLE = 37 * MiB;
constexpr size_t WS_SSMP = 38 * MiB;
constexpr size_t WS_RSTD = 39 * MiB;
constexpr size_t WS_SSQ = 40 * MiB;
constexpr size_t WS_F = 42 * MiB;
constexpr size_t WS_SIN = 50 * MiB;
constexpr size_t WS_PB = 58 * MiB;
constexpr size_t WS_XB = 72 * MiB;
constexpr size_t WS_MIX = WS_XB;
constexpr size_t WS_PROJ = 136 * MiB;
constexpr size_t WS_GB = 264 * MiB;
constexpr size_t WS_PLEB = 296 * MiB;
constexpr size_t WS_HB = 360 * MiB;
constexpr size_t WS_END = 424 * MiB;
constexpr int CW_BAR = 4096;

constexpr int RING_OFF = 0, RING_BYTES = 131072;
constexpr int LDSCTL_OFF = RING_BYTES, MISC_OFF = LDSCTL_OFF + 320;
constexpr int LDS_BYTES = 147456;

#define GAS __attribute__((address_space(1)))
#define LAS __attribute__((address_space(3)))
typedef unsigned short bf16;
typedef unsigned v4u __attribute__((ext_vector_type(4)));
typedef unsigned v2u __attribute__((ext_vector_type(2)));
typedef float f32x4 __attribute__((ext_vector_type(4)));
typedef float f32x16 __attribute__((ext_vector_type(16)));
typedef short bf16x8 __attribute__((ext_vector_type(8)));
typedef GAS unsigned gu32;
typedef GAS unsigned long long gu64;
#define RLX_AGENT __ATOMIC_RELAXED, __HIP_MEMORY_SCOPE_AGENT
#define LDS_WAIT() asm volatile("s_waitcnt lgkmcnt(0)" ::: "memory")
#define VM_WAIT() asm volatile("s_waitcnt vmcnt(0)" ::: "memory")
__device__ __forceinline__ int lane_id() { int l; asm volatile("v_mbcnt_lo_u32_b32 %0, -1, 0\n\tv_mbcnt_hi_u32_b32 %0, -1, %0" : "=v"(l)); return l; }
__device__ __forceinline__ unsigned f2bf(float f) { unsigned u = __builtin_bit_cast(unsigned, f); return (u + 0x7fffu + ((u >> 16) & 1u)) >> 16; }
__device__ __forceinline__ unsigned pk2(float lo, float hi) { return f2bf(lo) | (f2bf(hi) << 16); }
__device__ __forceinline__ float bflo(unsigned w) { return __uint_as_float(w << 16); }
__device__ __forceinline__ float bfhi(unsigned w) { return __uint_as_float(w & 0xffff0000u); }
__device__ __forceinline__ float bf1(bf16 v) { return __uint_as_float((unsigned)v << 16); }
__device__ __forceinline__ float sigm(float v) { return __builtin_amdgcn_rcpf(1.0f + __builtin_amdgcn_exp2f(-1.4426950408889634f * v)); }
__device__ __forceinline__ float gelu_tanh(float y) {
    const float t = 0.7978845608028654f * (y + 0.044715f * y * y * y); return y * sigm(2.0f * t); }

#define XB_TMO      128
#define XB_XCNT(j)  (256  + 64 * (j))
#define XB_XSUB(j)  (1280 + 64 * (j))
#define XB_XGEN(j)  (2304 + 64 * (j))
#define XB_TOP      3328
#define XB_TOPGEN   3392
#define XCD_BAR_WORDS 3456
#define XB_SPIN_CAP (1u << 18)

__device__ __forceinline__ unsigned xb_ld(unsigned* p)              { return __hip_atomic_load(p, __ATOMIC_RELAXED, __HIP_MEMORY_SCOPE_AGENT); }
__device__ __forceinline__ unsigned xb_add(unsigned* p, unsigned v) { return __hip_atomic_fetch_add(p, v, __ATOMIC_RELAXED, __HIP_MEMORY_SCOPE_AGENT); }
__device__ __forceinline__ unsigned xb_xcc_id() { return (unsigned)__builtin_amdgcn_s_getreg((3 << 11) | 20) & 0xFu; }
#define XB_SPIN(cond, bar) do { unsigned _sp = 0; while (cond) { __builtin_amdgcn_s_sleep(1); \
    if ((++_sp & 255u) == 0u) { if (xb_ld(&(bar)[XB_TMO])) break; if (_sp > XB_SPIN_CAP) { atomicAdd(&(bar)[XB_TMO], 1u); break; } } } } while (0)

struct XcdBarrier {
    unsigned* bar; unsigned x;
    volatile LAS unsigned* st;
    int w0;
};

__device__ __forceinline__ XcdBarrier xcd_barrier_post(unsigned* bar, volatile LAS unsigned* st) {
    XcdBarrier b; b.bar = bar; b.x = xb_xcc_id(); b.st = st; b.w0 = (__builtin_amdgcn_readfirstlane((int)(threadIdx.x >> 6)) == 0) ? 1 : 0;
    if (threadIdx.x == 0) (void)xb_add(&bar[XB_XCNT(b.x)], 1u);
    return b;
}
__device__ __forceinline__ void xcd_barrier_complete(unsigned* bar, unsigned x, unsigned& nloc, unsigned& nx) {
    const unsigned G = gridDim.x * gridDim.y * gridDim.z;
    unsigned sum, cnt, mine, sp = 0u;
    for (;;) {
        sum = 0u; cnt = 0u; mine = 0u;
#pragma unroll
        for (unsigned j = 0; j < 16; ++j) { const unsigned c = xb_ld(&bar[XB_XCNT(j)]); sum += c; cnt += (c > 0u) ? 1u : 0u; mine = (j == x) ? c : mine; }
        if (sum == G) break;
        __builtin_amdgcn_s_sleep(1);
        if ((++sp & 255u) == 0u) { if (xb_ld(&bar[XB_TMO])) break; if (sp > XB_SPIN_CAP) { atomicAdd(&bar[XB_TMO], 1u); break; } }
    }
    nloc = mine > 0u ? mine : 1u; nx = cnt > 0u ? cnt : 1u;
}

__device__ __forceinline__ void xcd_barrier(const XcdBarrier& b) {
    asm volatile("s_waitcnt vmcnt(0)" ::: "memory");
    __syncthreads();
    if (b.w0 != 0 && lane_id() == 0) {
        unsigned* bar = b.bar;
        __builtin_amdgcn_s_waitcnt(0);
        unsigned nloc = b.st[0], nx = b.st[1];
        if (nloc == 0u) { xcd_barrier_complete(bar, b.x, nloc, nx); b.st[0] = nloc; b.st[1] = nx; }
        const unsigned old = xb_add(&bar[XB_XSUB(b.x)], 1u);
        const unsigned gen = old / nloc;
        if (old + 1u == (gen + 1u) * nloc) {
            __builtin_amdgcn_fence(__ATOMIC_RELEASE, "agent");
            asm volatile("s_waitcnt vmcnt(0)" ::: "memory");
            const unsigned og = xb_add(&bar[XB_TOP], 1u);
            const unsigned tg = og / nx;
            if (og + 1u == (tg + 1u) * nx) xb_add(&bar[XB_TOPGEN], 1u);
            else XB_SPIN(xb_ld(&bar[XB_TOPGEN]) == tg, bar);
            __builtin_amdgcn_fence(__ATOMIC_ACQUIRE, "agent");
            xb_add(&bar[XB_XGEN(b.x)], 1u);
            asm volatile("s_waitcnt vmcnt(0)" ::: "memory");
        } else {
            XB_SPIN(xb_ld(&bar[XB_XGEN(b.x)]) == gen, bar);
            __builtin_amdgcn_fence(__ATOMIC_ACQUIRE, "agent");
            asm volatile("s_waitcnt vmcnt(0)" ::: "memory");
        }
    }
    __syncthreads();
}

struct Frame {
    LAS unsigned char* lds;
    volatile LAS unsigned* MISC;
    gu32* ctl;
    int wave;
    int vcu, G;
    const float *x, *p, *gain, *w_in, *w_pool, *pool_scale, *a_re, *a_im, *log_dt, *b_re, *b_im, *c_re, *c_im, *d_skip, *w_glu, *w_out, *w_ple, *w_gate, *final_gain;
    float* out; unsigned char* ws;
};
__device__ __forceinline__ float wave_sum(float v) {
#pragma unroll
    for (int o = 1; o < 64; o <<= 1) v += __shfl_xor(v, o);
    return v;
}

__device__ __forceinline__ void p0_transpose_item(const float* W, int ldw, int src_n0, int k0, const float* kscale, bf16* WT, int K, int dst_row0, LAS float* scr, int lane) {
#pragma unroll 8
    for (int i = 0; i < 32; ++i) { const int kk = 2 * i + (lane >> 5); float v = W[(size_t)(k0 + kk) * ldw + src_n0 + (lane & 31)]; if (kscale) v *= kscale[k0 + kk]; scr[kk * 33 + (lane & 31)] = v; }
    LDS_WAIT(); asm volatile("" ::: "memory");
    const int c = lane & 7;
#pragma unroll
    for (int j = 0; j < 4; ++j) { const int n = (lane >> 3) + 8 * j; const LAS float* s = scr + (8 * c) * 33 + n;
        v4u o; o.x = pk2(s[0 * 33], s[1 * 33]); o.y = pk2(s[2 * 33], s[3 * 33]); o.z = pk2(s[4 * 33], s[5 * 33]); o.w = pk2(s[6 * 33], s[7 * 33]);
        *(GAS v4u*)(WT + (size_t)(dst_row0 + n) * K + k0 + 8 * c) = o; }
    LDS_WAIT(); asm volatile("" ::: "memory");
}
__device__ __forceinline__ void p0_fold_item(Frame& F, int item, int lane) {
    const int g = item >> 9, db = (item >> 6) & 7, kb = item & 63, i = lane & 31, kh = lane >> 5;
    const float* Arow = F.w_in + (size_t)(kb * 32 + i) * NPROJ + g * 256 + 4 * kh;
    const float* Bp = F.w_pool + (size_t)g * 65536 + (size_t)(4 * kh) * 256 + db * 32 + i;
    f32x16 acc;
#pragma unroll
    for (int r = 0; r < 16; ++r) acc[r] = 0.f;
#pragma unroll 4
    for (int cb = 0; cb < 32; ++cb) {
        const f32x4 a = *(const f32x4*)(Arow + 8 * cb);
        const float b0 = Bp[(8 * cb + 0) * 256], b1 = Bp[(8 * cb + 1) * 256], b2 = Bp[(8 * cb + 2) * 256], b3 = Bp[(8 * cb + 3) * 256];
        acc = __builtin_amdgcn_mfma_f32_32x32x2f32(a[0], b0, acc, 0, 0, 0);
        acc = __builtin_amdgcn_mfma_f32_32x32x2f32(a[1], b1, acc, 0, 0, 0);
        acc = __builtin_amdgcn_mfma_f32_32x32x2f32(a[2], b2, acc, 0, 0, 0);
        acc = __builtin_amdgcn_mfma_f32_32x32x2f32(a[3], b3, acc, 0, 0, 0);
    }
    const int n = g * 256 + db * 32 + i; const float ps = F.pool_scale[n];
    bf16* WT = (bf16*)(F.ws + WS_WIN);
#pragma unroll
    for (int q = 0; q < 4; ++q) { const int k = kb * 32 + 8 * q + 4 * kh; const f32x4 gn = *(const f32x4*)(F.gain + k);
        v2u o; o.x = pk2(acc[4 * q] * gn[0] * ps, acc[4 * q + 1] * gn[1] * ps); o.y = pk2(acc[4 * q + 2] * gn[2] * ps, acc[4 * q + 3] * gn[3] * ps);
        *(GAS v2u*)(WT + (size_t)n * DM + k) = o; }
}
__device__ __forceinline__ void p0_x_row(const float* xrow, bf16* orow, float* rstd_out, int lane) {
    const GAS f32x4* xr = (const GAS f32x4*)xrow + lane;
    f32x4 v[8]; float s = 0.f;
#pragma unroll
    for (int j = 0; j < 8; ++j) { v[j] = xr[64 * j]; s += (v[j].x * v[j].x + v[j].y * v[j].y) + (v[j].z * v[j].z + v[j].w * v[j].w); }
    s = wave_sum(s);
    if (lane == 0) *rstd_out = 1.0f / sqrtf(s * (1.0f / DM) + RMS_EPS);
    GAS v2u* o = (GAS v2u*)orow + lane;
#pragma unroll
    for (int j = 0; j < 8; ++j) { v2u w; w.x = pk2(v[j].x, v[j].y); w.y = pk2(v[j].z, v[j].w); o[64 * j] = w; }
}
__device__ __forceinline__ void p0_prologue(Frame& F) {
    const int lane = lane_id();
    LAS float* scr = (LAS float*)(F.lds + RING_OFF + F.wave * 16384);
    const int gw = F.vcu * NWAVES + F.wave, NGW = F.G * NWAVES;
    constexpr int I_FOLD = 2048, I_IN = 32 * 96, I_GLU = 16 * 64, I_OUT = 32 * 64, I_GATE = 32 * 64, I_PLE = 4 * 64;
    constexpr int NITEMS = I_FOLD + I_IN + I_GLU + I_OUT + I_GATE + I_PLE;
    for (int it = gw; it < NITEMS; it += NGW) {
        int r = it;
        if (r < I_FOLD) { p0_fold_item(F, r, lane); continue; } r -= I_FOLD;
        if (r < I_IN) { const int kb = r / 96, nb = r % 96; p0_transpose_item(F.w_in, NPROJ, 1024 + 32 * nb, 64 * kb, F.gain, (bf16*)(F.ws + WS_WIN), DM, 1024 + 32 * nb, scr, lane); continue; } r -= I_IN;
        if (r < I_GLU) { const int kb = r / 64, nb = r % 64, n0 = 32 * nb; const int nn = n0 & 1023; const int drow = (nn >> 7) * 256 + (n0 >= 1024 ? 128 : 0) + (nn & 127);
            p0_transpose_item(F.w_glu, 2048, n0, 64 * kb, nullptr, (bf16*)(F.ws + WS_WGLU), SW, drow, scr, lane); continue; } r -= I_GLU;
        if (r < I_OUT) { const int kb = r / 64, nb = r % 64; p0_transpose_item(F.w_out, DM, 32 * nb, 64 * kb, nullptr, (bf16*)(F.ws + WS_WOUT), DM, 32 * nb, scr, lane); continue; } r -= I_OUT;
        if (r < I_GATE) { const int kb = r / 64, nb = r % 64; p0_transpose_item(F.w_gate, DM, 32 * nb, 64 * kb, nullptr, (bf16*)(F.ws + WS_WGATE), DM, 32 * nb, scr, lane); continue; } r -= I_GATE;
        { const int kb = r / 64, nb = r % 64; p0_transpose_item(F.w_ple, DM, 32 * nb, 64 * kb, nullptr, (bf16*)(F.ws + WS_WPLE), PLE, 32 * nb, scr, lane); }
    }
    for (int m = gw; m < M; m += NGW) p0_x_row(F.x + (size_t)m * DM, (bf16*)(F.ws + WS_XB) + (size_t)m * DM, (float*)(F.ws + WS_RSTD) + m, lane);
    { const GAS f32x4* ps = (const GAS f32x4*)F.p; GAS v2u* pd = (GAS v2u*)(F.ws + WS_PB);
      for (int idx = gw * 64 + lane; idx < M * PLE / 4; idx += NGW * 64) { const f32x4 v = ps[idx]; v2u w; w.x = pk2(v.x, v.y); w.y = pk2(v.z, v.w); pd[idx] = w; } }
}

__device__ __forceinline__ void ld8(const bf16* p, float (&v)[8]) { const v4u w = *(const GAS v4u*)p; v[0] = bflo(w.x); v[1] = bfhi(w.x); v[2] = bflo(w.y); v[3] = bfhi(w.y); v[4] = bflo(w.z); v[5] = bfhi(w.z); v[6] = bflo(w.w); v[7] = bfhi(w.w); }
__device__ __forceinline__ void window_phase(Frame& F) {
    const int lane = lane_id();
    const int gw = F.vcu * NWAVES + F.wave, NGW = F.G * NWAVES;
    const bf16* proj = (const bf16*)(F.ws + WS_PROJ); bf16* mix = (bf16*)(F.ws + WS_MIX);
    for (int item = gw; item < (M / 16) * 2; item += NGW) {
        const int m0 = (item >> 1) * 16, ch0 = (item & 1) * 512 + lane * 8, t0 = m0 & (SEQ - 1), w = 2 << (ch0 >> 8);
        float sum[8];
#pragma unroll
        for (int c = 0; c < 8; ++c) sum[c] = 0.f;
        for (int d = 1; d < 16; ++d) if (d < w && t0 - d >= 0) { float v[8]; ld8(proj + (size_t)(m0 - d) * NPROJ + ch0, v);
#pragma unroll
            for (int c = 0; c < 8; ++c) sum[c] += v[c]; }
        for (int i = 0; i < 16; ++i) { const int t = t0 + i; const size_t m = (size_t)(m0 + i);
            float v[8], gt[8]; ld8(proj + m * NPROJ + ch0, v); ld8(proj + m * NPROJ + PW + ch0, gt);
            const int cnt = (t + 1 < w) ? (t + 1) : w; const float rc = 1.0f / (float)cnt;
            float o[8];
#pragma unroll
            for (int c = 0; c < 8; ++c) { sum[c] += v[c]; o[c] = (sum[c] * rc - v[c]) * gt[c]; }
            v4u ow; ow.x = pk2(o[0], o[1]); ow.y = pk2(o[2], o[3]); ow.z = pk2(o[4], o[5]); ow.w = pk2(o[6], o[7]);
            *(GAS v4u*)(mix + m * DM + ch0) = ow;
            if (t - w + 1 >= 0) { float vo[8]; ld8(proj + (m - w + 1) * NPROJ + ch0, vo);
#pragma unroll
                for (int c = 0; c < 8; ++c) sum[c] -= vo[c]; } }
    }
}

__device__ __forceinline__ void ssm_simple_phase(Frame& F) {
    if (F.wave != 0) return;
    const int lane = lane_id();
    LAS float* red = (LAS float*)(F.lds + RING_OFF);
    const bf16* proj = (const bf16*)(F.ws + WS_PROJ); bf16* gb = (bf16*)(F.ws + WS_GB);
    for (int task = blockIdx.x; task < NBATCH * NG; task += F.G) {
        const int b = task / NG, g = task % NG, n = lane;
        const float lre = fminf(F.a_re[g * NS + n], -1e-4f), lim = F.a_im[g * NS + n];
        const float dt = expf(F.log_dt[g]);
        const float mag = expf(lre * dt), ang = lim * dt;
        const float abr = mag * cosf(ang), abi = mag * sinf(ang);
        const float den = lre * lre + lim * lim;
        const float nre = abr - 1.0f, nim = abi;
        const float qre = (nre * lre + nim * lim) / den, qim = (nim * lre - nre * lim) / den;
        float bbr[16], bbi[16], cr[16], ci[16];
#pragma unroll
        for (int c = 0; c < 16; ++c) {
            const float br = F.b_re[(g * NS + n) * SG + c], bi = F.b_im[(g * NS + n) * SG + c];
            bbr[c] = qre * br - qim * bi; bbi[c] = qre * bi + qim * br;
            cr[c] = F.c_re[(g * SG + c) * NS + n]; ci[c] = F.c_im[(g * SG + c) * NS + n];
        }
        const int cc = n & 15, q = n >> 4;
        const float dsk = F.d_skip[g * SG + cc];
        float sre = 0.f, sim = 0.f;
        for (int t = 0; t < SEQ; ++t) {
            const bf16* up = proj + (size_t)(b * SEQ + t) * NPROJ + 2 * PW + g * SG;
            float u[16]; { float u0[8], u1[8]; ld8(up, u0); ld8(up + 8, u1);
#pragma unroll
                for (int c = 0; c < 8; ++c) { u[c] = u0[c]; u[8 + c] = u1[c]; } }
            float bur = 0.f, bui = 0.f;
#pragma unroll
            for (int c = 0; c < 16; ++c) { bur = fmaf(bbr[c], u[c], bur); bui = fmaf(bbi[c], u[c], bui); }
            const float nr = abr * sre - abi * sim + bur, ni = abr * sim + abi * sre + bui;
            sre = nr; sim = ni;
#pragma unroll
            for (int c = 0; c < 16; ++c) red[c * 65 + n] = sre * cr[c] - sim * ci[c];
            LDS_WAIT(); asm volatile("" ::: "memory");
            float s = 0.f;
#pragma unroll
            for (int i = 0; i < 16; ++i) s += red[cc * 65 + q * 16 + i];
            LDS_WAIT(); asm volatile("" ::: "memory");
            s += __shfl_xor(s, 16); s += __shfl_xor(s, 32);
            float uc = 0.f;
#pragma unroll
            for (int c = 0; c < 16; ++c) uc = (c == cc) ? u[c] : uc;
            if (q == 0) { const float y = s + dsk * uc; gb[(size_t)(b * SEQ + t) * SW + g * SG + cc] = (bf16)f2bf(gelu_tanh(y)); }
        }
    }
}

__device__ __forceinline__ void final_phase(Frame& F) {
    const int lane = lane_id();
    const int gw = F.vcu * NWAVES + F.wave, NGW = F.G * NWAVES;
    const float* ssq = (const float*)(F.ws + WS_SSQ);
    for (int m = gw; m < M; m += NGW) {
        float s = (lane < 32) ? ssq[(size_t)m * 32 + lane] : 0.f;
        s = wave_sum(s);
        const float rs = 1.0f / sqrtf(s * (1.0f / DM) + RMS_EPS);
        GAS f32x4* o = (GAS f32x4*)(F.out + (size_t)m * DM) + lane; const GAS f32x4* gp = (const GAS f32x4*)F.final_gain + lane;
#pragma unroll
        for (int j = 0; j < 8; ++j) { const f32x4 v = o[64 * j], gn = gp[64 * j]; o[64 * j] = v * rs * gn; }
    }
}

struct Args { const float* in[19]; float* out; unsigned char* ws; };
__global__ void __launch_bounds__(NWAVES * 64, 2) mk_fwd(Args args) {
    extern __shared__ __attribute__((aligned(16))) unsigned char lds[];
    Frame F;
    F.lds = (LAS unsigned char*)lds;
    F.MISC = (volatile LAS unsigned*)(F.lds + MISC_OFF);
    F.wave = __builtin_amdgcn_readfirstlane((int)(threadIdx.x >> 6));
    F.G = gridDim.x; { const int bx = blockIdx.x; F.vcu = (F.G % 8 == 0) ? (bx % 8) * (F.G / 8) + bx / 8 : bx; }
    F.ws = args.ws; F.out = args.out; F.ctl = (gu32*)(args.ws + WS_CTL);
    F.x = args.in[0]; F.p = args.in[1]; F.gain = args.in[2]; F.w_in = args.in[3]; F.w_pool = args.in[4]; F.pool_scale = args.in[5];
    F.a_re = args.in[6]; F.a_im = args.in[7]; F.log_dt = args.in[8]; F.b_re = args.in[9]; F.b_im = args.in[10]; F.c_re = args.in[11]; F.c_im = args.in[12];
    F.d_skip = args.in[13]; F.w_glu = args.in[14]; F.w_out = args.in[15]; F.w_ple = args.in[16]; F.w_gate = args.in[17]; F.final_gain = args.in[18];
    for (int u = threadIdx.x; u < (LDS_BYTES - LDSCTL_OFF) / 4; u += NWAVES * 64) ((LAS unsigned*)(F.lds + LDSCTL_OFF))[u] = 0u;
    __syncthreads();
    XcdBarrier bar = xcd_barrier_post((unsigned*)(F.ctl + CW_BAR), F.MISC + 8);
    unsigned char* ws = args.ws;

    p0_prologue(F);
    xcd_barrier(bar);

    {   pg8::Gemm g{(const pg8::bf16_t*)(ws + WS_XB), (const pg8::bf16_t*)(ws + WS_WIN), M, NPROJ, DM}; pg8::StaticOrder S; S.init(M, NPROJ, F.G, (int)blockIdx.x);
        pg8::EpiProj E{(pg8::bf16_t*)(ws + WS_PROJ), (const float*)(ws + WS_RSTD), NPROJ};
        pg8::gemm_phase<pg8::EpiProj, pg8::StaticOrder, true, true>(F.lds + RING_OFF, g, S, E, F.wave); }
    {   pg8::Gemm g{(const pg8::bf16_t*)(ws + WS_PB), (const pg8::bf16_t*)(ws + WS_WPLE), M, DM, PLE}; pg8::StaticOrder S; S.init(M, DM, F.G, (int)blockIdx.x);
        pg8::EpiStore E{(pg8::bf16_t*)(ws + WS_PLEB), DM};
        pg8::gemm_phase<pg8::EpiStore, pg8::StaticOrder, true, true>(F.lds + RING_OFF, g, S, E, F.wave); }
    xcd_barrier(bar);

    window_phase(F);
    ssm_simple_phase(F);
    xcd_barrier(bar);

    {   pg8::Gemm g{(const pg8::bf16_t*)(ws + WS_GB), (const pg8::bf16_t*)(ws + WS_WGLU), M, 2048, SW}; pg8::StaticOrder S; S.init(M, 2048, F.G, (int)blockIdx.x);
        pg8::EpiGlu E{(pg8::bf16_t*)(ws + WS_MIX), (const pg8::bf16_t*)(ws + WS_PROJ)};
        pg8::gemm_phase<pg8::EpiGlu, pg8::StaticOrder, true, true>(F.lds + RING_OFF, g, S, E, F.wave); }
    xcd_barrier(bar);

    {   pg8::Gemm g{(const pg8::bf16_t*)(ws + WS_MIX), (const pg8::bf16_t*)(ws + WS_WOUT), M, DM, DM}; pg8::StaticOrder S; S.init(M, DM, F.G, (int)blockIdx.x);
        pg8::EpiH E{F.x, F.out, (pg8::bf16_t*)(ws + WS_HB)};
        pg8::gemm_phase<pg8::EpiH, pg8::StaticOrder, true, true>(F.lds + RING_OFF, g, S, E, F.wave); }
    xcd_barrier(bar);

    {   pg8::Gemm g{(const pg8::bf16_t*)(ws + WS_HB), (const pg8::bf16_t*)(ws + WS_WGATE), M, DM, DM}; pg8::StaticOrder S; S.init(M, DM, F.G, (int)blockIdx.x);
        pg8::EpiGate E{F.out, (const pg8::bf16_t*)(ws + WS_PLEB), (float*)(ws + WS_SSQ)};
        pg8::gemm_phase<pg8::EpiGate, pg8::StaticOrder, true, true>(F.lds + RING_OFF, g, S, E, F.wave); }
    xcd_barrier(bar);

    final_phase(F);
}

extern "C" void kernel_launch(void* const* d_in, const int* in_sizes, int n_in, void* d_out, int out_size, void* d_ws, size_t ws_size, hipStream_t stream) {
    static int grid = 0;
    if (grid == 0) {
        if (n_in != 19 || in_sizes[0] != M * DM || out_size != M * DM || ws_size < WS_END) {
            fprintf(stderr, "kernel_launch: built for 19 inputs, x/out of %d floats, >= %zu B of workspace; got n_in %d, in0 %d, out %d, ws %zu\n", M * DM, (size_t)WS_END, n_in, n_in > 0 ? in_sizes[0] : -1, out_size, ws_size); grid = -1; return; }
        int dev = 0, cus = 0, per_cu = 0;
        if (hipGetDevice(&dev) != hipSuccess || hipDeviceGetAttribute(&cus, hipDeviceAttributeMultiprocessorCount, dev) != hipSuccess) { fprintf(stderr, "kernel_launch: device query failed\n"); grid = -1; return; }
        if (hipFuncSetAttribute((const void*)mk_fwd, hipFuncAttributeMaxDynamicSharedMemorySize, LDS_BYTES) != hipSuccess) { fprintf(stderr, "kernel_launch: hipFuncSetAttribute failed\n"); grid = -1; return; }
        if (hipOccupancyMaxActiveBlocksPerMultiprocessor(&per_cu, (const void*)mk_fwd, NWAVES * 64, LDS_BYTES) != hipSuccess || per_cu < 1) {
            fprintf(stderr, "kernel_launch: occupancy query reports %d workgroups per CU\n", per_cu); (void)hipGetLastError(); grid = -1; return; }
        grid = cus;
    }
    if (grid < 0) return;
    if (hipMemsetAsync((char*)d_ws + WS_CTL, 0, CTL_ZERO_BYTES, stream) != hipSuccess) { fprintf(stderr, "kernel_launch: memset failed\n"); return; }
    Args a{};
    for (int i = 0; i < 19; ++i) a.in[i] = (const float*)d_in[i];
    a.out = (float*)d_out; a.ws = (unsigned char*)d_ws;
    hipLaunchKernelGGL(mk_fwd, dim3(grid), dim3(NWAVES * 64), LDS_BYTES, stream, a);
}
```

```cpp
#include <hip/hip_runtime.h>
#include <cstdio>
#include <cstdint>
namespace pg8 {
#define PG8_LAS __attribute__((address_space(3)))
typedef unsigned short bf16_t;
typedef short bf16x8 __attribute__((ext_vector_type(8)));
typedef float f32x4 __attribute__((ext_vector_type(4)));
typedef unsigned u32x4 __attribute__((ext_vector_type(4)));
constexpr int BM = 256, BK = 64, HALF = 128, HTB = HALF * BK * 2  , STAGE_BYTES = 8 * HTB, NXCD = 8, WGM = 8;

__host__ __device__ __forceinline__ int lds_byte(int r, int c) { const int st = (r >> 4) * 2 + (c >> 5), rr = r & 15, cc = c & 31, ob = rr * 64 + cc * 2; return st * 1024 + (ob ^ (((ob >> 9) & 1) << 5)); }
__host__ __device__ __forceinline__ void stage_rc(int b, int& R, int& C) { const int st = b / 1024, sb = b % 1024, swz = sb ^ (((sb >> 9) & 1) << 5); R = (st >> 1) * 16 + swz / 64; C = (st & 1) * 32 + (swz % 64) / 2; }
__host__ __device__ __forceinline__ int perm32(int rho) { const int n = rho >> 4, i = rho & 15; return 8 * (i >> 2) + 4 * n + (i & 3); }

struct Unit { int pm, pn; };
struct Gemm { const bf16_t* A; const bf16_t* Bt; int M, N, K; };

struct StaticOrder {
    int nM, nN, nwg, G, c;
    __host__ __device__ void init(int M, int N, int G_, int c_) { nM = M / BM; nN = N / BM; nwg = nM * nN; G = G_; c = c_; }
    __host__ __device__ bool next(int i, Unit& u) const {
        const long L = (long)i * G + c; if (L >= nwg) return false;
        int wgid = (int)L; { const int q = nwg / NXCD, r = nwg % NXCD, xcd = wgid % NXCD, off = wgid / NXCD; wgid = (xcd < r ? xcd * (q + 1) : r * (q + 1) + (xcd - r) * q) + off; }
        const int nig = WGM * nN, gid = wgid / nig, fm = gid * WGM, gsz = (nM - fm) < WGM ? (nM - fm) : WGM;
        u.pm = fm + ((wgid % nig) % gsz); u.pn = (wgid % nig) / gsz; return true;
    }
    __device__ __forceinline__ void a_ready(const Unit&) const {}
    __device__ __forceinline__ void done(const Unit&) const {}
};

__device__ __forceinline__ unsigned cvt_pk_bf16(float lo, float hi) { unsigned r; asm volatile("v_cvt_pk_bf16_f32 %0, %1, %2" : "=v"(r) : "v"(lo), "v"(hi)); return r; }
typedef float f32x2 __attribute__((ext_vector_type(2)));
__device__ __forceinline__ float fsigmoid(float v) { return __builtin_amdgcn_rcpf(1.0f + __builtin_amdgcn_exp2f(-1.4426950408889634f * v)); }
__device__ __forceinline__ float bf_lo(unsigned w) { return __uint_as_float(w << 16); }
__device__ __forceinline__ float bf_hi(unsigned w) { return __uint_as_float(w & 0xffff0000u); }
__device__ __forceinline__ u32x4 pack8(const f32x4 a, const f32x4 b) { u32x4 w; w.x = cvt_pk_bf16(a[0], a[1]); w.y = cvt_pk_bf16(a[2], a[3]); w.z = cvt_pk_bf16(b[0], b[1]); w.w = cvt_pk_bf16(b[2], b[3]); return w; }

struct EpiProj {
    static constexpr bool PERM = true, AFTER_DRAIN = false;
    bf16_t* O; const float* rstd; int ldc;
    __device__ __forceinline__ void operator()(const f32x4 (&acc)[2][2][4][2], const Unit& u, int wr, int wc, int fr, int fq) const {
        const int row0 = u.pm * BM + wr * 64 + fr, col0 = u.pn * BM + wc * 32 + 8 * fq; const bool gate = ((u.pn >> 2) & 1) != 0;
#pragma unroll
        for (int ai = 0; ai < 2; ++ai)
#pragma unroll
            for (int m = 0; m < 4; ++m) { const int row = row0 + ai * HALF + m * 16; const float rs = rstd[row]; bf16_t* rowp = O + (size_t)row * ldc + col0;
#pragma unroll
                for (int bj = 0; bj < 2; ++bj) { f32x4 v0 = acc[ai][bj][m][0] * rs, v1 = acc[ai][bj][m][1] * rs;
                    if (gate) {
#pragma unroll
                        for (int i = 0; i < 4; ++i) { v0[i] = v0[i] * fsigmoid(v0[i]); v1[i] = v1[i] * fsigmoid(v1[i]); } }
                    *(u32x4*)(rowp + bj * HALF) = pack8(v0, v1); } }
    }
};
struct EpiStore {
    static constexpr bool PERM = true, AFTER_DRAIN = false;
    bf16_t* O; int ldc;
    __device__ __forceinline__ void operator()(const f32x4 (&acc)[2][2][4][2], const Unit& u, int wr, int wc, int fr, int fq) const {
        const int row0 = u.pm * BM + wr * 64 + fr, col0 = u.pn * BM + wc * 32 + 8 * fq;
#pragma unroll
        for (int ai = 0; ai < 2; ++ai)
#pragma unroll
            for (int m = 0; m < 4; ++m) { bf16_t* rowp = O + (size_t)(row0 + ai * HALF + m * 16) * ldc + col0;
#pragma unroll
                for (int bj = 0; bj < 2; ++bj) *(u32x4*)(rowp + bj * HALF) = pack8(acc[ai][bj][m][0], acc[ai][bj][m][1]); }
    }
};
struct EpiGlu {
    static constexpr bool PERM = true, AFTER_DRAIN = false;
    bf16_t* mix; const bf16_t* proj;
    __device__ __forceinline__ void operator()(const f32x4 (&acc)[2][2][4][2], const Unit& u, int wr, int wc, int fr, int fq) const {
        const int row0 = u.pm * BM + wr * 64 + fr, colg = u.pn * HALF + wc * 32 + 8 * fq;
#pragma unroll
        for (int ai = 0; ai < 2; ++ai)
#pragma unroll
            for (int m = 0; m < 4; ++m) { const int row = row0 + ai * HALF + m * 16;
                const u32x4 sg = *(const u32x4*)(proj + (size_t)row * 4096 + 3072 + colg);
                const f32x4 s0 = (f32x4){bf_lo(sg.x), bf_hi(sg.x), bf_lo(sg.y), bf_hi(sg.y)}, s1 = (f32x4){bf_lo(sg.z), bf_hi(sg.z), bf_lo(sg.w), bf_hi(sg.w)};
                f32x4 o0, o1;
#pragma unroll
                for (int i = 0; i < 4; ++i) { o0[i] = acc[ai][0][m][0][i] * fsigmoid(acc[ai][1][m][0][i]) * s0[i]; o1[i] = acc[ai][0][m][1][i] * fsigmoid(acc[ai][1][m][1][i]) * s1[i]; }
                *(u32x4*)(mix + (size_t)row * 2048 + 1024 + colg) = pack8(o0, o1); }
    }
};
struct EpiH {
    static constexpr bool PERM = true, AFTER_DRAIN = false;
    const float* x; float* h; bf16_t* hb;
    __device__ __forceinline__ void operator()(const f32x4 (&acc)[2][2][4][2], const Unit& u, int wr, int wc, int fr, int fq) const {
        const int row0 = u.pm * BM + wr * 64 + fr, col0 = u.pn * BM + wc * 32 + 8 * fq;
#pragma unroll
        for (int ai = 0; ai < 2; ++ai)
#pragma unroll
            for (int m = 0; m < 4; ++m) { const size_t rb = (size_t)(row0 + ai * HALF + m * 16) * 2048 + col0;
#pragma unroll
                for (int bj = 0; bj < 2; ++bj) { const size_t off = rb + bj * HALF;
                    const f32x4 h0 = *(const f32x4*)(x + off) + acc[ai][bj][m][0], h1 = *(const f32x4*)(x + off + 4) + acc[ai][bj][m][1];
                    *(f32x4*)(h + off) = h0; *(f32x4*)(h + off + 4) = h1; *(u32x4*)(hb + off) = pack8(h0, h1); } }
    }
};
struct EpiGate {
    static constexpr bool PERM = true, AFTER_DRAIN = false;
    float* h; const bf16_t* ple; float* ssq;
    __device__ __forceinline__ void operator()(const f32x4 (&acc)[2][2][4][2], const Unit& u, int wr, int wc, int fr, int fq) const {
        const int row0 = u.pm * BM + wr * 64 + fr, col0 = u.pn * BM + wc * 32 + 8 * fq;
#pragma unroll
        for (int ai = 0; ai < 2; ++ai)
#pragma unroll
            for (int m = 0; m < 4; ++m) { const int row = row0 + ai * HALF + m * 16; const size_t rb = (size_t)row * 2048 + col0; float q = 0.f;
#pragma unroll
                for (int bj = 0; bj < 2; ++bj) { const size_t off = rb + bj * HALF;
                    f32x4 h0 = *(const f32x4*)(h + off), h1 = *(const f32x4*)(h + off + 4); const u32x4 pl = *(const u32x4*)(ple + off);
                    const f32x4 p0 = (f32x4){bf_lo(pl.x), bf_hi(pl.x), bf_lo(pl.y), bf_hi(pl.y)}, p1 = (f32x4){bf_lo(pl.z), bf_hi(pl.z), bf_lo(pl.w), bf_hi(pl.w)};
#pragma unroll
                    for (int i = 0; i < 4; ++i) { h0[i] += p0[i] * fsigmoid(acc[ai][bj][m][0][i]); h1[i] += p1[i] * fsigmoid(acc[ai][bj][m][1][i]); q += h0[i] * h0[i] + h1[i] * h1[i]; }
                    *(f32x4*)(h + off) = h0; *(f32x4*)(h + off + 4) = h1; }
                q += __shfl_xor(q, 16); q += __shfl_xor(q, 32);
                if (fq == 0) ssq[(size_t)row * 32 + u.pn * 4 + wc] = q; }
    }
};

template <class Epi, class Sched, bool ALIGN_EPI = false, bool SP2 = false>
__device__ __forceinline__ void gemm_phase(PG8_LAS unsigned char* lds, const Gemm g, const Sched& S, const Epi& E, const int wave_id) {
    int lane_; asm volatile("v_mbcnt_lo_u32_b32 %0, -1, 0\n\tv_mbcnt_hi_u32_b32 %0, -1, %0" : "=v"(lane_));
    const int wid = wave_id, tid = wave_id * 64 + lane_, lane = tid & 63, wr = wid >> 2, wc = wid & 3, fr = lane & 15, fq = lane >> 4;
    const int K = g.K, nt = K / BK;
    unsigned voffA[2], voffB[2];
#pragma unroll
    for (int i = 0; i < 2; ++i) { int R, C; stage_rc(tid * 16 + i * 8192, R, C); const int Rb = Epi::PERM ? ((R & ~31) + perm32(R & 31)) : R;
        voffA[i] = (unsigned)(R * K + C) * 2u; voffB[i] = (unsigned)(Rb * K + C) * 2u; }
    const size_t kstep = (size_t)(BK * 2);
    const size_t hstep = (size_t)HALF * K * 2;
    const size_t tstep = 2 * hstep;
    const unsigned ldsw = (unsigned)wid * 1024u;
    const int aoff = lds_byte(wr * 64 + fr, fq * 8), boff = lds_byte(wc * 32 + fr, fq * 8);
#define PG8_SA(b, h) (((b) * 2 + (h)) * HTB)
#define PG8_SB(b, h) ((4 + (b) * 2 + (h)) * HTB)
#define PG8_STAGE(bufoff, gbase, voff) do { _Pragma("unroll") for (int _i = 0; _i < 2; ++_i) \
        __builtin_amdgcn_global_load_lds((const unsigned*)((const char*)(gbase) + (voff)[_i]), (PG8_LAS unsigned*)(lds + (bufoff) + ldsw + _i * 8192), 16, 0, 0); } while (0)
#define PG8_LDA(dst, b, h) do { _Pragma("unroll") for (int m = 0; m < 4; ++m) _Pragma("unroll") for (int k = 0; k < 2; ++k) dst[m][k] = *(const PG8_LAS bf16x8*)(lds + PG8_SA(b, h) + aoff + m * 2048 + k * 1024); } while (0)
#define PG8_LDB(dst, b, h) do { _Pragma("unroll") for (int n = 0; n < 2; ++n) _Pragma("unroll") for (int k = 0; k < 2; ++k) dst[n][k] = *(const PG8_LAS bf16x8*)(lds + PG8_SB(b, h) + boff + n * 2048 + k * 1024); } while (0)
#define PG8_MMA(ai, bj, At, Bt) do { __builtin_amdgcn_s_setprio(1); _Pragma("unroll") for (int m = 0; m < 4; ++m) _Pragma("unroll") for (int n = 0; n < 2; ++n) _Pragma("unroll") for (int k = 0; k < 2; ++k) \
        acc[ai][bj][m][n] = __builtin_amdgcn_mfma_f32_16x16x32_bf16(Bt[n][k], At[m][k], acc[ai][bj][m][n], 0, 0, 0); __builtin_amdgcn_s_setprio(0); } while (0)
#define PG8_WAIT_V(n) asm volatile("s_waitcnt vmcnt(" #n ")" ::: "memory")
#define PG8_WAIT_L(n) asm volatile("s_waitcnt lgkmcnt(" #n ")" ::: "memory")
#define PG8_BAR __builtin_amdgcn_s_barrier()
#define PG8_SCHED __builtin_amdgcn_sched_barrier(0)
    Unit cur, nxt; int ui = 0;
    if (!S.next(0, cur)) return;
    f32x4 acc[2][2][4][2];
#pragma unroll
    for (int a = 0; a < 2; ++a)
#pragma unroll
        for (int b = 0; b < 2; ++b)
#pragma unroll
            for (int m = 0; m < 4; ++m)
#pragma unroll
                for (int n = 0; n < 2; ++n) acc[a][b][m][n] = (f32x4){0.f, 0.f, 0.f, 0.f};
    bf16x8 At[4][2], B0[2][2], B1[2][2];
    const char* cA = (const char*)g.A + (size_t)cur.pm * tstep; const char* cB = (const char*)g.Bt + (size_t)cur.pn * tstep;
    S.a_ready(cur);
    if constexpr (SP2) {
        PG8_STAGE(PG8_SB(0, 0), cB, voffB); PG8_STAGE(PG8_SB(0, 1), cB + hstep, voffB); PG8_STAGE(PG8_SA(0, 0), cA, voffA); PG8_STAGE(PG8_SA(0, 1), cA + hstep, voffA);
        if (wr == 1) PG8_BAR;
        PG8_WAIT_V(2); PG8_BAR;
        PG8_STAGE(PG8_SB(1, 0), cB + kstep, voffB); PG8_STAGE(PG8_SA(1, 0), cA + kstep, voffA); PG8_STAGE(PG8_SB(1, 1), cB + hstep + kstep, voffB);
        PG8_WAIT_V(6); PG8_BAR;
    } else {
        PG8_STAGE(PG8_SB(0, 0), cB, voffB); PG8_STAGE(PG8_SA(0, 0), cA, voffA); PG8_STAGE(PG8_SB(0, 1), cB + hstep, voffB); PG8_STAGE(PG8_SA(0, 1), cA + hstep, voffA);
        if (wr == 1) PG8_BAR;
        PG8_WAIT_V(4); PG8_BAR;
        PG8_STAGE(PG8_SB(1, 0), cB + kstep, voffB); PG8_STAGE(PG8_SA(1, 0), cA + kstep, voffA); PG8_STAGE(PG8_SB(1, 1), cB + hstep + kstep, voffB);
        PG8_WAIT_V(6); PG8_BAR;
    }
    for (;;) {
        const bool has_next = S.next(ui + 1, nxt);
        const char* nA = has_next ? (const char*)g.A + (size_t)nxt.pm * tstep : cA; const char* nB = has_next ? (const char*)g.Bt + (size_t)nxt.pn * tstep : cB;
        for (int t = 0; t < nt; t += 2) {
            const bool last = (t == nt - 2);
            const char* a1 = cA + (size_t)(t + 1) * kstep;
            const char* a2 = last ? nA : cA + (size_t)(t + 2) * kstep; const char* b2 = last ? nB : cB + (size_t)(t + 2) * kstep;
            const char* a3 = a2 + kstep; const char* b3 = b2 + kstep;
            if (last && has_next) S.a_ready(nxt);
            if constexpr (SP2) {
            PG8_LDB(B0, 0, 0); PG8_LDB(B1, 0, 1); PG8_SCHED; PG8_LDA(At, 0, 0); PG8_STAGE(PG8_SA(1, 1), a1 + hstep, voffA);
            PG8_WAIT_V(8); PG8_WAIT_L(0); PG8_BAR; PG8_MMA(0, 0, At, B0); PG8_MMA(0, 1, At, B1); PG8_BAR; PG8_SCHED;
            PG8_LDA(At, 0, 1); PG8_STAGE(PG8_SB(0, 0), b2, voffB); PG8_STAGE(PG8_SB(0, 1), b2 + hstep, voffB); PG8_STAGE(PG8_SA(0, 0), a2, voffA);
            PG8_WAIT_V(8); PG8_WAIT_L(0); PG8_BAR; PG8_MMA(1, 0, At, B0); PG8_MMA(1, 1, At, B1); PG8_BAR; PG8_SCHED;
            PG8_LDB(B0, 1, 0); PG8_LDB(B1, 1, 1); PG8_SCHED; PG8_LDA(At, 1, 0); PG8_STAGE(PG8_SA(0, 1), a2 + hstep, voffA);
            PG8_WAIT_V(8); PG8_WAIT_L(0); PG8_BAR; PG8_MMA(0, 0, At, B0); PG8_MMA(0, 1, At, B1); PG8_BAR; PG8_SCHED;
            PG8_LDA(At, 1, 1); PG8_STAGE(PG8_SB(1, 0), b3, voffB); PG8_STAGE(PG8_SB(1, 1), b3 + hstep, voffB); PG8_STAGE(PG8_SA(1, 0), a3, voffA);
            PG8_WAIT_V(8); PG8_WAIT_L(0); PG8_BAR; PG8_MMA(1, 0, At, B0); PG8_MMA(1, 1, At, B1); PG8_BAR; PG8_SCHED;
            } else {
            PG8_LDB(B0, 0, 0); PG8_SCHED; PG8_LDA(At, 0, 0); PG8_STAGE(PG8_SA(1, 1), a1 + hstep, voffA);
            PG8_WAIT_L(8); PG8_BAR; PG8_WAIT_L(0); PG8_MMA(0, 0, At, B0); PG8_BAR; PG8_SCHED;
            PG8_LDB(B1, 0, 1); PG8_STAGE(PG8_SB(0, 0), b2, voffB);
            PG8_BAR; PG8_WAIT_L(0); PG8_MMA(0, 1, At, B1); PG8_BAR;
            PG8_LDA(At, 0, 1); PG8_STAGE(PG8_SA(0, 0), a2, voffA);
            PG8_BAR; PG8_WAIT_L(0); PG8_MMA(1, 0, At, B0); PG8_BAR; PG8_SCHED;
            PG8_STAGE(PG8_SB(0, 1), b2 + hstep, voffB);
            PG8_WAIT_V(6); PG8_BAR; PG8_MMA(1, 1, At, B1); PG8_BAR;
            PG8_LDB(B0, 1, 0); PG8_SCHED; PG8_LDA(At, 1, 0); PG8_STAGE(PG8_SA(0, 1), a2 + hstep, voffA);
            PG8_WAIT_L(8); PG8_BAR; PG8_WAIT_L(0); PG8_MMA(0, 0, At, B0); PG8_BAR; PG8_SCHED;
            PG8_LDB(B1, 1, 1); PG8_STAGE(PG8_SB(1, 0), b3, voffB);
            PG8_BAR; PG8_WAIT_L(0); PG8_MMA(0, 1, At, B1); PG8_BAR;
            PG8_LDA(At, 1, 1); PG8_STAGE(PG8_SA(1, 0), a3, voffA);
            PG8_BAR; PG8_WAIT_L(0); PG8_MMA(1, 0, At, B0); PG8_BAR; PG8_SCHED;
            PG8_STAGE(PG8_SB(1, 1), b3 + hstep, voffB);
            PG8_WAIT_V(6); PG8_BAR; PG8_MMA(1, 1, At, B1); PG8_BAR;
            }
        }
        if constexpr (ALIGN_EPI) { if (wr == 0) PG8_BAR; }
        if constexpr (!Epi::AFTER_DRAIN) { E(acc, cur, wr, wc, fr, fq); S.done(cur); }
        if (!has_next) break;
#pragma unroll
        for (int a = 0; a < 2; ++a)
#pragma unroll
            for (int b = 0; b < 2; ++b)
#pragma unroll
                for (int m = 0; m < 4; ++m)
#pragma unroll
                    for (int n = 0; n < 2; ++n) acc[a][b][m][n] = (f32x4){0.f, 0.f, 0.f, 0.f};
        cur = nxt; cA = nA; cB = nB; ++ui;
        if constexpr (ALIGN_EPI) { if (wr == 1) PG8_BAR; }
    }
    PG8_WAIT_V(0);
    if constexpr (!ALIGN_EPI) { if (wr == 0) PG8_BAR; }
    PG8_BAR;
    if constexpr (Epi::AFTER_DRAIN) { E.fused(acc, cur, wr, wc, fr, fq, lds, wid, lane); S.done(cur); }
#undef PG8_SA
#undef PG8_SB
#undef PG8_STAGE
#undef PG8_LDA
#undef PG8_LDB
#undef PG8_MMA
#undef PG8_WAIT_V
#undef PG8_WAIT_L
#undef PG8_BAR
#undef PG8_SCHED
}
}
constexpr int NWAVES = 8;
constexpr int DM = 2048, NBATCH = 4, SEQ = 4096, M = NBATCH * SEQ;
constexpr int NPROJ = 4096, PW = 1024, SW = 1024, PLE = 256;
constexpr int NG = 64, SG = 16, NS = 64;
constexpr float RMS_EPS = 1e-6f;

constexpr size_t MiB = 1u << 20;
constexpr size_t WS_CTL = 0, CTL_ZERO_BYTES = 1 * MiB;
constexpr size_t WS_WIN = 1 * MiB;
constexpr size_t WS_WGLU = 17 * MiB;
constexpr size_t WS_WOUT = 21 * MiB;
constexpr size_t WS_WGATE = 29 * MiB;
constexpr size_t WS_WPLE = 37 * MiB;
constexpr size_t WS_SSMP = 38 * MiB;
constexpr size_t WS_RSTD = 39 * MiB;
constexpr size_t WS_SSQ = 40 * MiB;
constexpr size_t WS_F = 42 * MiB;
constexpr size_t WS_SIN = 50 * MiB;
constexpr size_t WS_PB = 58 * MiB;
constexpr size_t WS_XB = 72 * MiB;
constexpr size_t WS_MIX = WS_XB;
constexpr size_t WS_PROJ = 136 * MiB;
constexpr size_t WS_GB = 264 * MiB;
constexpr size_t WS_PLEB = 296 * MiB;
constexpr size_t WS_HB = 360 * MiB;
constexpr size_t WS_END = 424 * MiB;
constexpr int CW_BAR = 4096;

constexpr int RING_OFF = 0, RING_BYTES = 131072;
constexpr int LDSCTL_OFF = RING_BYTES, MISC_OFF = LDSCTL_OFF + 320;
constexpr int LDS_BYTES = 147456;

#define GAS __attribute__((address_space(1)))
#define LAS __attribute__((address_space(3)))
typedef unsigned short bf16;
typedef unsigned v4u __attribute__((ext_vector_type(4)));
typedef unsigned v2u __attribute__((ext_vector_type(2)));
typedef float f32x4 __attribute__((ext_vector_type(4)));
typedef float f32x16 __attribute__((ext_vector_type(16)));
typedef short bf16x8 __attribute__((ext_vector_type(8)));
typedef GAS unsigned gu32;
typedef GAS unsigned long long gu64;
#define RLX_AGENT __ATOMIC_RELAXED, __HIP_MEMORY_SCOPE_AGENT
#define LDS_WAIT() asm volatile("s_waitcnt lgkmcnt(0)" ::: "memory")
#define VM_WAIT() asm volatile("s_waitcnt vmcnt(0)" ::: "memory")
__device__ __forceinline__ int lane_id() { int l; asm volatile("v_mbcnt_lo_u32_b32 %0, -1, 0\n\tv_mbcnt_hi_u32_b32 %0, -1, %0" : "=v"(l)); return l; }
__device__ __forceinline__ unsigned f2bf(float f) { unsigned u = __builtin_bit_cast(unsigned, f); return (u + 0x7fffu + ((u >> 16) & 1u)) >> 16; }
__device__ __forceinline__ unsigned pk2(float lo, float hi) { return f2bf(lo) | (f2bf(hi) << 16); }
__device__ __forceinline__ float bflo(unsigned w) { return __uint_as_float(w << 16); }
__device__ __forceinline__ float bfhi(unsigned w) { return __uint_as_float(w & 0xffff0000u); }
__device__ __forceinline__ float bf1(bf16 v) { return __uint_as_float((unsigned)v << 16); }
__device__ __forceinline__ float sigm(float v) { return __builtin_amdgcn_rcpf(1.0f + __builtin_amdgcn_exp2f(-1.4426950408889634f * v)); }
__device__ __forceinline__ float gelu_tanh(float y) {
    const float t = 0.7978845608028654f * (y + 0.044715f * y * y * y); return y * sigm(2.0f * t); }

#define XB_TMO      128
#define XB_XCNT(j)  (256  + 64 * (j))
#define XB_XSUB(j)  (1280 + 64 * (j))
#define XB_XGEN(j)  (2304 + 64 * (j))
#define XB_TOP      3328
#define XB_TOPGEN   3392
#define XCD_BAR_WORDS 3456
#define XB_SPIN_CAP (1u << 18)

__device__ __forceinline__ unsigned xb_ld(unsigned* p)              { return __hip_atomic_load(p, __ATOMIC_RELAXED, __HIP_MEMORY_SCOPE_AGENT); }
__device__ __forceinline__ unsigned xb_add(unsigned* p, unsigned v) { return __hip_atomic_fetch_add(p, v, __ATOMIC_RELAXED, __HIP_MEMORY_SCOPE_AGENT); }
__device__ __forceinline__ unsigned xb_xcc_id() { return (unsigned)__builtin_amdgcn_s_getreg((3 << 11) | 20) & 0xFu; }
#define XB_SPIN(cond, bar) do { unsigned _sp = 0; while (cond) { __builtin_amdgcn_s_sleep(1); \
    if ((++_sp & 255u) == 0u) { if (xb_ld(&(bar)[XB_TMO])) break; if (_sp > XB_SPIN_CAP) { atomicAdd(&(bar)[XB_TMO], 1u); break; } } } } while (0)

struct XcdBarrier {
    unsigned* bar; unsigned x;
    volatile LAS unsigned* st;
    int w0;
};

__device__ __forceinline__ XcdBarrier xcd_barrier_post(unsigned* bar, volatile LAS unsigned* st) {
    XcdBarrier b; b.bar = bar; b.x = xb_xcc_id(); b.st = st; b.w0 = (__builtin_amdgcn_readfirstlane((int)(threadIdx.x >> 6)) == 0) ? 1 : 0;
    if (threadIdx.x == 0) (void)xb_add(&bar[XB_XCNT(b.x)], 1u);
    return b;
}
__device__ __forceinline__ void xcd_barrier_complete(unsigned* bar, unsigned x, unsigned& nloc, unsigned& nx) {
    const unsigned G = gridDim.x * gridDim.y * gridDim.z;
    unsigned sum, cnt, mine, sp = 0u;
    for (;;) {
        sum = 0u; cnt = 0u; mine = 0u;
#pragma unroll
        for (unsigned j = 0; j < 16; ++j) { const unsigned c = xb_ld(&bar[XB_XCNT(j)]); sum += c; cnt += (c > 0u) ? 1u : 0u; mine = (j == x) ? c : mine; }
        if (sum == G) break;
        __builtin_amdgcn_s_sleep(1);
        if ((++sp & 255u) == 0u) { if (xb_ld(&bar[XB_TMO])) break; if (sp > XB_SPIN_CAP) { atomicAdd(&bar[XB_TMO], 1u); break; } }
    }
    nloc = mine > 0u ? mine : 1u; nx = cnt > 0u ? cnt : 1u;
}

__device__ __forceinline__ void xcd_barrier(const XcdBarrier& b) {
    asm volatile("s_waitcnt vmcnt(0)" ::: "memory");
    __syncthreads();
    if (b.w0 != 0 && lane_id() == 0) {
        unsigned* bar = b.bar;
        __builtin_amdgcn_s_waitcnt(0);
        unsigned nloc = b.st[0], nx = b.st[1];
        if (nloc == 0u) { xcd_barrier_complete(bar, b.x, nloc, nx); b.st[0] = nloc; b.st[1] = nx; }
        const unsigned old = xb_add(&bar[XB_XSUB(b.x)], 1u);
        const unsigned gen = old / nloc;
        if (old + 1u == (gen + 1u) * nloc) {
            __builtin_amdgcn_fence(__ATOMIC_RELEASE, "agent");
            asm volatile("s_waitcnt vmcnt(0)" ::: "memory");
            const unsigned og = xb_add(&bar[XB_TOP], 1u);
            const unsigned tg = og / nx;
            if (og + 1u == (tg + 1u) * nx) xb_add(&bar[XB_TOPGEN], 1u);
            else XB_SPIN(xb_ld(&bar[XB_TOPGEN]) == tg, bar);
            __builtin_amdgcn_fence(__ATOMIC_ACQUIRE, "agent");
            xb_add(&bar[XB_XGEN(b.x)], 1u);
            asm volatile("s_waitcnt vmcnt(0)" ::: "memory");
        } else {
            XB_SPIN(xb_ld(&bar[XB_XGEN(b.x)]) == gen, bar);
            __builtin_amdgcn_fence(__ATOMIC_ACQUIRE, "agent");
            asm volatile("s_waitcnt vmcnt(0)" ::: "memory");
        }
    }
    __syncthreads();
}

struct Frame {
    LAS unsigned char* lds;
    volatile LAS unsigned* MISC;
    gu32* ctl;
    int wave;
    int vcu, G;
    const float *x, *p, *gain, *w_in, *w_pool, *pool_scale, *a_re, *a_im, *log_dt, *b_re, *b_im, *c_re, *c_im, *d_skip, *w_glu, *w_out, *w_ple, *w_gate, *final_gain;
    float* out; unsigned char* ws;
};
__device__ __forceinline__ float wave_sum(float v) {
#pragma unroll
    for (int o = 1; o < 64; o <<= 1) v += __shfl_xor(v, o);
    return v;
}

__device__ __forceinline__ void p0_transpose_item(const float* W, int ldw, int src_n0, int k0, const float* kscale, bf16* WT, int K, int dst_row0, LAS float* scr, int lane) {
#pragma unroll 8
    for (int i = 0; i < 32; ++i) { const int kk = 2 * i + (lane >> 5); float v = W[(size_t)(k0 + kk) * ldw + src_n0 + (lane & 31)]; if (kscale) v *= kscale[k0 + kk]; scr[kk * 33 + (lane & 31)] = v; }
    LDS_WAIT(); asm volatile("" ::: "memory");
    const int c = lane & 7;
#pragma unroll
    for (int j = 0; j < 4; ++j) { const int n = (lane >> 3) + 8 * j; const LAS float* s = scr + (8 * c) * 33 + n;
        v4u o; o.x = pk2(s[0 * 33], s[1 * 33]); o.y = pk2(s[2 * 33], s[3 * 33]); o.z = pk2(s[4 * 33], s[5 * 33]); o.w = pk2(s[6 * 33], s[7 * 33]);
        *(GAS v4u*)(WT + (size_t)(dst_row0 + n) * K + k0 + 8 * c) = o; }
    LDS_WAIT(); asm volatile("" ::: "memory");
}
__device__ __forceinline__ void p0_fold_item(Frame& F, int item, int lane) {
    const int g = item >> 9, db = (item >> 6) & 7, kb = item & 63, i = lane & 31, kh = lane >> 5;
    const float* Arow = F.w_in + (size_t)(kb * 32 + i) * NPROJ + g * 256 + 4 * kh;
    const float* Bp = F.w_pool + (size_t)g * 65536 + (size_t)(4 * kh) * 256 + db * 32 + i;
    f32x16 acc;
#pragma unroll
    for (int r = 0; r < 16; ++r) acc[r] = 0.f;
#pragma unroll 4
    for (int cb = 0; cb < 32; ++cb) {
        const f32x4 a = *(const f32x4*)(Arow + 8 * cb);
        const float b0 = Bp[(8 * cb + 0) * 256], b1 = Bp[(8 * cb + 1) * 256], b2 = Bp[(8 * cb + 2) * 256], b3 = Bp[(8 * cb + 3) * 256];
        acc = __builtin_amdgcn_mfma_f32_32x32x2f32(a[0], b0, acc, 0, 0, 0);
        acc = __builtin_amdgcn_mfma_f32_32x32x2f32(a[1], b1, acc, 0, 0, 0);
        acc = __builtin_amdgcn_mfma_f32_32x32x2f32(a[2], b2, acc, 0, 0, 0);
        acc = __builtin_amdgcn_mfma_f32_32x32x2f32(a[3], b3, acc, 0, 0, 0);
    }
    const int n = g * 256 + db * 32 + i; const float ps = F.pool_scale[n];
    bf16* WT = (bf16*)(F.ws + WS_WIN);
#pragma unroll
    for (int q = 0; q < 4; ++q) { const int k = kb * 32 + 8 * q + 4 * kh; const f32x4 gn = *(const f32x4*)(F.gain + k);
        v2u o; o.x = pk2(acc[4 * q] * gn[0] * ps, acc[4 * q + 1] * gn[1] * ps); o.y = pk2(acc[4 * q + 2] * gn[2] * ps, acc[4 * q + 3] * gn[3] * ps);
        *(GAS v2u*)(WT + (size_t)n * DM + k) = o; }
}
__device__ __forceinline__ void p0_x_row(const float* xrow, bf16* orow, float* rstd_out, int lane) {
    const GAS f32x4* xr = (const GAS f32x4*)xrow + lane;
    f32x4 v[8]; float s = 0.f;
#pragma unroll
    for (int j = 0; j < 8; ++j) { v[j] = xr[64 * j]; s += (v[j].x * v[j].x + v[j].y * v[j].y) + (v[j].z * v[j].z + v[j].w * v[j].w); }
    s = wave_sum(s);
    if (lane == 0) *rstd_out = 1.0f / sqrtf(s * (1.0f / DM) + RMS_EPS);
    GAS v2u* o = (GAS v2u*)orow + lane;
#pragma unroll
    for (int j = 0; j < 8; ++j) { v2u w; w.x = pk2(v[j].x, v[j].y); w.y = pk2(v[j].z, v[j].w); o[64 * j] = w; }
}
__device__ __forceinline__ void p0_ssm_params(Frame& F, int g, int lane);
__device__ __forceinline__ void p0_prologue(Frame& F) {
    const int lane = lane_id();
    LAS float* scr = (LAS float*)(F.lds + RING_OFF + F.wave * 16384);
    const int gw = F.vcu * NWAVES + F.wave, NGW = F.G * NWAVES;
    constexpr int I_FOLD = 2048, I_IN = 32 * 96, I_GLU = 16 * 64, I_OUT = 32 * 64, I_GATE = 32 * 64, I_PLE = 4 * 64;
    constexpr int NITEMS = I_FOLD + I_IN + I_GLU + I_OUT + I_GATE + I_PLE;
    for (int it = gw; it < NITEMS; it += NGW) {
        int r = it;
        if (r < I_FOLD) { p0_fold_item(F, r, lane); continue; } r -= I_FOLD;
        if (r < I_IN) { const int kb = r / 96, nb = r % 96; p0_transpose_item(F.w_in, NPROJ, 1024 + 32 * nb, 64 * kb, F.gain, (bf16*)(F.ws + WS_WIN), DM, 1024 + 32 * nb, scr, lane); continue; } r -= I_IN;
        if (r < I_GLU) { const int kb = r / 64, nb = r % 64, n0 = 32 * nb; const int nn = n0 & 1023; const int drow = (nn >> 7) * 256 + (n0 >= 1024 ? 128 : 0) + (nn & 127);
            p0_transpose_item(F.w_glu, 2048, n0, 64 * kb, nullptr, (bf16*)(F.ws + WS_WGLU), SW, drow, scr, lane); continue; } r -= I_GLU;
        if (r < I_OUT) { const int kb = r / 64, nb = r % 64; p0_transpose_item(F.w_out, DM, 32 * nb, 64 * kb, nullptr, (bf16*)(F.ws + WS_WOUT), DM, 32 * nb, scr, lane); continue; } r -= I_OUT;
        if (r < I_GATE) { const int kb = r / 64, nb = r % 64; p0_transpose_item(F.w_gate, DM, 32 * nb, 64 * kb, nullptr, (bf16*)(F.ws + WS_WGATE), DM, 32 * nb, scr, lane); continue; } r -= I_GATE;
        { const int kb = r / 64, nb = r % 64; p0_transpose_item(F.w_ple, DM, 32 * nb, 64 * kb, nullptr, (bf16*)(F.ws + WS_WPLE), PLE, 32 * nb, scr, lane); }
    }
    for (int g = gw; g < NG; g += NGW) p0_ssm_params(F, g, lane);
    for (int m = gw; m < M; m += NGW) p0_x_row(F.x + (size_t)m * DM, (bf16*)(F.ws + WS_XB) + (size_t)m * DM, (float*)(F.ws + WS_RSTD) + m, lane);
    { const GAS f32x4* ps = (const GAS f32x4*)F.p; GAS v2u* pd = (GAS v2u*)(F.ws + WS_PB);
      for (int idx = gw * 64 + lane; idx < M * PLE / 4; idx += NGW * 64) { const f32x4 v = ps[idx]; v2u w; w.x = pk2(v.x, v.y); w.y = pk2(v.z, v.w); pd[idx] = w; } }
}

__device__ __forceinline__ void ld8(const bf16* p, float (&v)[8]) { const v4u w = *(const GAS v4u*)p; v[0] = bflo(w.x); v[1] = bfhi(w.x); v[2] = bflo(w.y); v[3] = bfhi(w.y); v[4] = bflo(w.z); v[5] = bfhi(w.z); v[6] = bflo(w.w); v[7] = bfhi(w.w); }
__device__ __forceinline__ void window_phase(Frame& F) {
    const int lane = lane_id();
    const int gw = F.vcu * NWAVES + F.wave, NGW = F.G * NWAVES;
    const bf16* proj = (const bf16*)(F.ws + WS_PROJ); bf16* mix = (bf16*)(F.ws + WS_MIX);
    for (int item = gw; item < (M / 16) * 2; item += NGW) {
        const int m0 = (item >> 1) * 16, ch0 = (item & 1) * 512 + lane * 8, t0 = m0 & (SEQ - 1), w = 2 << (ch0 >> 8);
        float sum[8];
#pragma unroll
        for (int c = 0; c < 8; ++c) sum[c] = 0.f;
        for (int d = 1; d < 16; ++d) if (d < w && t0 - d >= 0) { float v[8]; ld8(proj + (size_t)(m0 - d) * NPROJ + ch0, v);
#pragma unroll
            for (int c = 0; c < 8; ++c) sum[c] += v[c]; }
        for (int i = 0; i < 16; ++i) { const int t = t0 + i; const size_t m = (size_t)(m0 + i);
            float v[8], gt[8]; ld8(proj + m * NPROJ + ch0, v); ld8(proj + m * NPROJ + PW + ch0, gt);
            const int cnt = (t + 1 < w) ? (t + 1) : w; const float rc = 1.0f / (float)cnt;
            float o[8];
#pragma unroll
            for (int c = 0; c < 8; ++c) { sum[c] += v[c]; o[c] = (sum[c] * rc - v[c]) * gt[c]; }
            v4u ow; ow.x = pk2(o[0], o[1]); ow.y = pk2(o[2], o[3]); ow.z = pk2(o[4], o[5]); ow.w = pk2(o[6], o[7]);
            *(GAS v4u*)(mix + m * DM + ch0) = ow;
            if (t - w + 1 >= 0) { float vo[8]; ld8(proj + (m - w + 1) * NPROJ + ch0, vo);
#pragma unroll
                for (int c = 0; c < 8; ++c) sum[c] -= vo[c]; } }
    }
}

constexpr size_t SP_ABR = 0, SP_ABI = 16384, SP_A64R = 32768, SP_A64I = 49152, SP_BB = 65536, SP_CCK = SP_BB + 262144;
typedef __bf16 bf2_t __attribute__((ext_vector_type(2)));
typedef float f2_t __attribute__((ext_vector_type(2)));
__device__ __forceinline__ unsigned cvt2(float lo, float hi) { const f2_t v = {lo, hi}; return __builtin_bit_cast(unsigned, __builtin_convertvector(v, bf2_t)); }
__device__ __forceinline__ void p0_ssm_params(Frame& F, int g, int lane) {
    const int n = lane;
    const float lre = fminf(F.a_re[g * NS + n], -1e-4f), lim = F.a_im[g * NS + n];
    const float dt = expf(F.log_dt[g]);
    const float mag = expf(lre * dt), ang = lim * dt;
    const float abr = mag * cosf(ang), abi = mag * sinf(ang);
    const float den = lre * lre + lim * lim;
    const float nre = abr - 1.0f, nim = abi;
    const float qre = (nre * lre + nim * lim) / den, qim = (nim * lre - nre * lim) / den;
    float* sp = (float*)(F.ws + WS_SSMP);
    sp[g * 64 + n] = abr; sp[4096 + g * 64 + n] = abi;
    float pr = abr, pi = abi;
#pragma unroll
    for (int i = 0; i < 6; ++i) { const float r2 = pr * pr - pi * pi, i2 = 2.0f * pr * pi; pr = r2; pi = i2; }
    sp[8192 + g * 64 + n] = pr; sp[12288 + g * 64 + n] = pi;
    unsigned wre[8], wim[8];
#pragma unroll
    for (int c2 = 0; c2 < 8; ++c2) {
        const float br0 = F.b_re[(g * NS + n) * SG + 2 * c2], bi0 = F.b_im[(g * NS + n) * SG + 2 * c2], br1 = F.b_re[(g * NS + n) * SG + 2 * c2 + 1], bi1 = F.b_im[(g * NS + n) * SG + 2 * c2 + 1];
        wre[c2] = pk2(qre * br0 - qim * bi0, qre * br1 - qim * bi1); wim[c2] = pk2(qre * bi0 + qim * br0, qre * bi1 + qim * br1);
    }
    bf16* bb = (bf16*)(F.ws + WS_SSMP + SP_BB) + (size_t)g * 128 * 16;
    *(GAS v4u*)(bb + n * 16) = (v4u){wre[0], wre[1], wre[2], wre[3]}; *(GAS v4u*)(bb + n * 16 + 8) = (v4u){wre[4], wre[5], wre[6], wre[7]};
    *(GAS v4u*)(bb + (64 + n) * 16) = (v4u){wim[0], wim[1], wim[2], wim[3]}; *(GAS v4u*)(bb + (64 + n) * 16 + 8) = (v4u){wim[4], wim[5], wim[6], wim[7]};
    bf16* cck = (bf16*)(F.ws + WS_SSMP + SP_CCK) + (size_t)g * 16 * 128;
    for (int i = 0; i < 32; ++i) { const int idx = lane + 64 * i, c = idx >> 7, kap = idx & 127, np = 32 * (kap & 3) + (kap >> 2);
        const float val = (np < 64) ? F.c_re[(g * SG + c) * NS + np] : -F.c_im[(g * SG + c) * NS + np - 64];
        cck[c * 128 + kap] = (bf16)f2bf(val); }
}
template <bool PASS2>
__device__ __forceinline__ void ssm_pass(Frame& F) {
    const int lane = lane_id();
    const int gw = F.vcu * NWAVES + F.wave, NGW = F.G * NWAVES;
    const int l31 = lane & 31, h = lane >> 5, l15 = lane & 15, qq = lane >> 4;
    const bf16* proj = (const bf16*)(F.ws + WS_PROJ); bf16* gb = (bf16*)(F.ws + WS_GB);
    const float* sp = (const float*)(F.ws + WS_SSMP);
    const bf16* bb = (const bf16*)(F.ws + WS_SSMP + SP_BB); const bf16* cck = (const bf16*)(F.ws + WS_SSMP + SP_CCK);
    float* fbuf = (float*)(F.ws + WS_F); const float* sin = (const float*)(F.ws + WS_SIN);
    LAS unsigned char* st = F.lds + RING_OFF + F.wave * 8704;
    const int pr = (l31 >> 2) & 1, tau = (l31 & 3) + 4 * (l31 >> 3);
    for (int task = gw; task < NG * 128; task += NGW) {
        const int g = task & 63, pp = task >> 6;
        const float ar0 = sp[g * 64 + l31], ai0 = sp[4096 + g * 64 + l31], ar1 = sp[g * 64 + 32 + l31], ai1 = sp[4096 + g * 64 + 32 + l31];
        bf16x8 bfrag[4], cfrag[4];
#pragma unroll
        for (int j = 0; j < 4; ++j) bfrag[j] = *(const GAS bf16x8*)(bb + ((size_t)(g * 128 + 32 * j + l31) * 16 + 8 * h));
        if (PASS2) {
#pragma unroll
            for (int ks = 0; ks < 4; ++ks) cfrag[ks] = *(const GAS bf16x8*)(cck + ((size_t)(g * 16 + l15) * 128 + 32 * ks + 8 * qq)); }
        const size_t sbase = ((size_t)(pp + 128 * h) * 64 + g) * 128;
        float sre0 = 0.f, sre1 = 0.f, sim0 = 0.f, sim1 = 0.f;
        if (PASS2) { sre0 = sin[sbase + l31]; sre1 = sin[sbase + 32 + l31]; sim0 = sin[sbase + 64 + l31]; sim1 = sin[sbase + 96 + l31]; }
        const bf16* arow = proj + (size_t)(64 * (pp + 128 * pr) + tau) * NPROJ + 2 * PW + g * SG + 8 * h;
        const float dsk = F.d_skip[g * SG + l15];
        for (int s = 0; s < 4; ++s) {
            const bf16x8 afrag = *(const GAS bf16x8*)(arow + (size_t)(16 * s) * NPROJ);
            f32x16 z;
#pragma unroll
            for (int r = 0; r < 16; ++r) z[r] = 0.f;
            const f32x16 D0 = __builtin_amdgcn_mfma_f32_32x32x16_bf16(afrag, bfrag[0], z, 0, 0, 0), D1 = __builtin_amdgcn_mfma_f32_32x32x16_bf16(afrag, bfrag[1], z, 0, 0, 0),
                         D2 = __builtin_amdgcn_mfma_f32_32x32x16_bf16(afrag, bfrag[2], z, 0, 0, 0), D3 = __builtin_amdgcn_mfma_f32_32x32x16_bf16(afrag, bfrag[3], z, 0, 0, 0);
#pragma unroll
            for (int r = 0; r < 16; ++r) {
                const float nr0 = fmaf(ar0, sre0, fmaf(-ai0, sim0, D0[r])), ni0 = fmaf(ar0, sim0, fmaf(ai0, sre0, D2[r]));
                const float nr1 = fmaf(ar1, sre1, fmaf(-ai1, sim1, D1[r])), ni1 = fmaf(ar1, sim1, fmaf(ai1, sre1, D3[r]));
                sre0 = nr0; sim0 = ni0; sre1 = nr1; sim1 = ni1;
                if (PASS2) { v2u w; w.x = cvt2(nr0, nr1); w.y = cvt2(ni0, ni1); *(LAS v2u*)(st + (16 * h + r) * 272 + 8 * l31) = w; }
            }
            if (PASS2) {
                LDS_WAIT(); asm volatile("" ::: "memory");
                f32x4 acc0 = (f32x4){0.f, 0.f, 0.f, 0.f}, acc1 = (f32x4){0.f, 0.f, 0.f, 0.f};
#pragma unroll
                for (int ks = 0; ks < 4; ++ks) {
                    const bf16x8 s0 = *(const LAS bf16x8*)(st + l15 * 272 + 64 * ks + 16 * qq), s1 = *(const LAS bf16x8*)(st + (16 + l15) * 272 + 64 * ks + 16 * qq);
                    acc0 = __builtin_amdgcn_mfma_f32_16x16x32_bf16(s0, cfrag[ks], acc0, 0, 0, 0); acc1 = __builtin_amdgcn_mfma_f32_16x16x32_bf16(s1, cfrag[ks], acc1, 0, 0, 0); }
                LDS_WAIT(); asm volatile("" ::: "memory");
#pragma unroll
                for (int rb = 0; rb < 2; ++rb)
#pragma unroll
                    for (int i = 0; i < 4; ++i) { const size_t m = (size_t)(64 * (pp + 128 * rb) + 16 * s + 4 * qq + i);
                        const float u = bf1(proj[m * NPROJ + 2 * PW + g * SG + l15]);
                        const float y = (rb == 0 ? acc0[i] : acc1[i]) + dsk * u;
                        gb[m * SW + g * SG + l15] = (bf16)(cvt2(gelu_tanh(y), 0.f) & 0xffffu); }
            }
        }
        if (!PASS2) { fbuf[sbase + l31] = sre0; fbuf[sbase + 32 + l31] = sre1; fbuf[sbase + 64 + l31] = sim0; fbuf[sbase + 96 + l31] = sim1; }
    }
}
__device__ __forceinline__ void ssm_carry_phase(Frame& F) {
    if (F.wave != 0) return;
    const int lane = lane_id();
    const float* sp = (const float*)(F.ws + WS_SSMP); const float* fbuf = (const float*)(F.ws + WS_F); float* sin = (float*)(F.ws + WS_SIN);
    for (int task = F.vcu; task < NBATCH * NG; task += F.G) {
        const int b = task >> 6, g = task & 63;
        const float a_r = sp[8192 + g * 64 + lane], a_i = sp[12288 + g * 64 + lane];
        float cr = 0.f, ci = 0.f;
        for (int c0 = 0; c0 < 64; c0 += 16) {
            float fr[16], fi[16];
#pragma unroll
            for (int k = 0; k < 16; ++k) { const size_t base = ((size_t)(b * 64 + c0 + k) * 64 + g) * 128; fr[k] = fbuf[base + lane]; fi[k] = fbuf[base + 64 + lane]; }
#pragma unroll
            for (int k = 0; k < 16; ++k) { const size_t base = ((size_t)(b * 64 + c0 + k) * 64 + g) * 128; sin[base + lane] = cr; sin[base + 64 + lane] = ci;
                const float nr = fmaf(a_r, cr, fmaf(-a_i, ci, fr[k])), ni = fmaf(a_r, ci, fmaf(a_i, cr, fi[k])); cr = nr; ci = ni; }
        }
    }
}

__device__ __forceinline__ void final_phase(Frame& F) {
    const int lane = lane_id();
    const int gw = F.vcu * NWAVES + F.wave, NGW = F.G * NWAVES;
    const float* ssq = (const float*)(F.ws + WS_SSQ);
    for (int m = gw; m < M; m += NGW) {
        float s = (lane < 32) ? ssq[(size_t)m * 32 + lane] : 0.f;
        s = wave_sum(s);
        const float rs = 1.0f / sqrtf(s * (1.0f / DM) + RMS_EPS);
        GAS f32x4* o = (GAS f32x4*)(F.out + (size_t)m * DM) + lane; const GAS f32x4* gp = (const GAS f32x4*)F.final_gain + lane;
#pragma unroll
        for (int j = 0; j < 8; ++j) { const f32x4 v = o[64 * j], gn = gp[64 * j]; o[64 * j] = v * rs * gn; }
    }
}

struct Args { const float* in[19]; float* out; unsigned char* ws; };
__global__ void __launch_bounds__(NWAVES * 64, 2) mk_fwd(Args args) {
    extern __shared__ __attribute__((aligned(16))) unsigned char lds[];
    Frame F;
    F.lds = (LAS unsigned char*)lds;
    F.MISC = (volatile LAS unsigned*)(F.lds + MISC_OFF);
    F.wave = __builtin_amdgcn_readfirstlane((int)(threadIdx.x >> 6));
    F.G = gridDim.x; { const int bx = blockIdx.x; F.vcu = (F.G % 8 == 0) ? (bx % 8) * (F.G / 8) + bx / 8 : bx; }
    F.ws = args.ws; F.out = args.out; F.ctl = (gu32*)(args.ws + WS_CTL);
    F.x = args.in[0]; F.p = args.in[1]; F.gain = args.in[2]; F.w_in = args.in[3]; F.w_pool = args.in[4]; F.pool_scale = args.in[5];
    F.a_re = args.in[6]; F.a_im = args.in[7]; F.log_dt = args.in[8]; F.b_re = args.in[9]; F.b_im = args.in[10]; F.c_re = args.in[11]; F.c_im = args.in[12];
    F.d_skip = args.in[13]; F.w_glu = args.in[14]; F.w_out = args.in[15]; F.w_ple = args.in[16]; F.w_gate = args.in[17]; F.final_gain = args.in[18];
    for (int u = threadIdx.x; u < (LDS_BYTES - LDSCTL_OFF) / 4; u += NWAVES * 64) ((LAS unsigned*)(F.lds + LDSCTL_OFF))[u] = 0u;
    __syncthreads();
    XcdBarrier bar = xcd_barrier_post((unsigned*)(F.ctl + CW_BAR), F.MISC + 8);
    unsigned char* ws = args.ws;

    p0_prologue(F);
    xcd_barrier(bar);

    {   pg8::Gemm g{(const pg8::bf16_t*)(ws + WS_XB), (const pg8::bf16_t*)(ws + WS_WIN), M, NPROJ, DM}; pg8::StaticOrder S; S.init(M, NPROJ, F.G, (int)blockIdx.x);
        pg8::EpiProj E{(pg8::bf16_t*)(ws + WS_PROJ), (const float*)(ws + WS_RSTD), NPROJ};
        pg8::gemm_phase<pg8::EpiProj, pg8::StaticOrder, true, true>(F.lds + RING_OFF, g, S, E, F.wave); }
    {   pg8::Gemm g{(const pg8::bf16_t*)(ws + WS_PB), (const pg8::bf16_t*)(ws + WS_WPLE), M, DM, PLE}; pg8::StaticOrder S; S.init(M, DM, F.G, (int)blockIdx.x);
        pg8::EpiStore E{(pg8::bf16_t*)(ws + WS_PLEB), DM};
        pg8::gemm_phase<pg8::EpiStore, pg8::StaticOrder, true, true>(F.lds + RING_OFF, g, S, E, F.wave); }
    xcd_barrier(bar);

    window_phase(F);
    ssm_pass<false>(F);
    xcd_barrier(bar);
    ssm_carry_phase(F);
    xcd_barrier(bar);
    ssm_pass<true>(F);
    xcd_barrier(bar);

    {   pg8::Gemm g{(const pg8::bf16_t*)(ws + WS_GB), (const pg8::bf16_t*)(ws + WS_WGLU), M, 2048, SW}; pg8::StaticOrder S; S.init(M, 2048, F.G, (int)blockIdx.x);
        pg8::EpiGlu E{(pg8::bf16_t*)(ws + WS_MIX), (const pg8::bf16_t*)(ws + WS_PROJ)};
        pg8::gemm_phase<pg8::EpiGlu, pg8::StaticOrder, true, true>(F.lds + RING_OFF, g, S, E, F.wave); }
    xcd_barrier(bar);

    {   pg8::Gemm g{(const pg8::bf16_t*)(ws + WS_MIX), (const pg8::bf16_t*)(ws + WS_WOUT), M, DM, DM}; pg8::StaticOrder S; S.init(M, DM, F.G, (int)blockIdx.x);
        pg8::EpiH E{F.x, F.out, (pg8::bf16_t*)(ws + WS_HB)};
        pg8::gemm_phase<pg8::EpiH, pg8::StaticOrder, true, true>(F.lds + RING_OFF, g, S, E, F.wave); }
    xcd_barrier(bar);

    {   pg8::Gemm g{(const pg8::bf16_t*)(ws + WS_HB), (const pg8::bf16_t*)(ws + WS_WGATE), M, DM, DM}; pg8::StaticOrder S; S.init(M, DM, F.G, (int)blockIdx.x);
        pg8::EpiGate E{F.out, (const pg8::bf16_t*)(ws + WS_PLEB), (float*)(ws + WS_SSQ)};
        pg8::gemm_phase<pg8::EpiGate, pg8::StaticOrder, true, true>(F.lds + RING_OFF, g, S, E, F.wave); }
    xcd_barrier(bar);

    final_phase(F);
}

extern "C" void kernel_launch(void* const* d_in, const int* in_sizes, int n_in, void* d_out, int out_size, void* d_ws, size_t ws_size, hipStream_t stream) {
    static int grid = 0;
    if (grid == 0) {
        if (n_in != 19 || in_sizes[0] != M * DM || out_size != M * DM || ws_size < WS_END) {
            fprintf(stderr, "kernel_launch: built for 19 inputs, x/out of %d floats, >= %zu B of workspace; got n_in %d, in0 %d, out %d, ws %zu\n", M * DM, (size_t)WS_END, n_in, n_in > 0 ? in_sizes[0] : -1, out_size, ws_size); grid = -1; return; }
        int dev = 0, cus = 0, per_cu = 0;
        if (hipGetDevice(&dev) != hipSuccess || hipDeviceGetAttribute(&cus, hipDeviceAttributeMultiprocessorCount, dev) != hipSuccess) { fprintf(stderr, "kernel_launch: device query failed\n"); grid = -1; return; }
        if (hipFuncSetAttribute((const void*)mk_fwd, hipFuncAttributeMaxDynamicSharedMemorySize, LDS_BYTES) != hipSuccess) { fprintf(stderr, "kernel_launch: hipFuncSetAttribute failed\n"); grid = -1; return; }
        if (hipOccupancyMaxActiveBlocksPerMultiprocessor(&per_cu, (const void*)mk_fwd, NWAVES * 64, LDS_BYTES) != hipSuccess || per_cu < 1) {
            fprintf(stderr, "kernel_launch: occupancy query reports %d workgroups per CU\n", per_cu); (void)hipGetLastError(); grid = -1; return; }
        grid = cus;
    }
    if (grid < 0) return;
    if (hipMemsetAsync((char*)d_ws + WS_CTL, 0, CTL_ZERO_BYTES, stream) != hipSuccess) { fprintf(stderr, "kernel_launch: memset failed\n"); return; }
    Args a{};
    for (int i = 0; i < 19; ++i) a.in[i] = (const float*)d_in[i];
    a.out = (float*)d_out; a.ws = (unsigned char*)d_ws;
    hipLaunchKernelGGL(mk_fwd, dim3(grid), dim3(NWAVES * 64), LDS_BYTES, stream, a);
}
```
